# Optimizing an MI355X kernel written in HIP

```python
import math
import jax, jax.numpy as jnp
from jax import lax
import numpy as np

D_MODEL = 2048
BATCH = 1
SEQ = 8192
DEPTH = 1

GLA_WIDTH = D_MODEL // 2
GLA_HEADS = 4
GLA_DK = (GLA_WIDTH // 2) // GLA_HEADS
GLA_DV = GLA_WIDTH // GLA_HEADS
GLA_GATE_RANK = 16
GLA_TAU = 16.0
GLA_CHUNK = 64
ATT_WIDTH = D_MODEL - GLA_WIDTH
ATT_HEADS = 8
ATT_HD = ATT_WIDTH // ATT_HEADS
DILATED_BRANCHES = ((128, 1), (512, 4), (2048, 16))
BAND_BLOCK = 128
ROPE_THETA = 10000.0
D_FF = 5632
CONV_WIDTH = 3
DEEPNORM_ALPHA = (2.0 * DEPTH) ** 0.25
DEEPNORM_BETA = (8.0 * DEPTH) ** -0.25
ADA_STD = 0.005
LN_EPS = 1e-5
RMS_EPS = 1e-6
MAX_POS_OFFSET = 1024
IN_SIZES = (GLA_HEADS * GLA_DK, GLA_HEADS * GLA_DK, GLA_WIDTH, GLA_WIDTH, GLA_GATE_RANK,
            ATT_WIDTH, ATT_WIDTH, ATT_WIDTH)
IN_IS_VALUE = (False, False, True, False, False, False, False, True)
IN_COLS = sum(IN_SIZES)

kernel_name = "hymba_gla_longnet_convffn_deepnorm_adaln"


def split_sizes(t, sizes):
    out, start = [], 0
    for n in sizes:
        out.append(t[..., start:start + n])
        start += n
    return out


def layer_norm(x, g, b):
    xf = x.astype(jnp.float32)
    mu = jnp.mean(xf, axis=-1, keepdims=True)
    var = jnp.mean(jnp.square(xf - mu), axis=-1, keepdims=True)
    return ((xf - mu) * lax.rsqrt(var + LN_EPS) * g.astype(jnp.float32) + b.astype(jnp.float32)).astype(x.dtype)


def rotary(t, positions):
    half = t.shape[-1] // 2
    inv_freq = ROPE_THETA ** (-jnp.arange(half, dtype=jnp.float32) / half)
    ang = positions.astype(jnp.float32)[..., None] * inv_freq
    cos = jnp.cos(ang)[:, :, None, :]
    sin = jnp.sin(ang)[:, :, None, :]
    t1 = t[..., :half].astype(jnp.float32)
    t2 = t[..., half:].astype(jnp.float32)
    return jnp.concatenate([t1 * cos - t2 * sin, t2 * cos + t1 * sin], axis=-1).astype(t.dtype)


def gla_chunked(q, k, v, log_a):
    B, S, H, dk = q.shape
    dv = v.shape[-1]
    nc = S // GLA_CHUNK

    def chunks(t):
        return t.reshape(B, nc, GLA_CHUNK, H, t.shape[-1]).transpose(1, 0, 3, 2, 4)

    causal = jnp.tril(jnp.ones((GLA_CHUNK, GLA_CHUNK), dtype=bool))[:, :, None]

    def step(state, inp):
        qc, kc, vc, gc = inp
        b = jnp.cumsum(gc, axis=-2)
        diff = b[..., :, None, :] - b[..., None, :, :]
        decay = jnp.exp(jnp.where(causal, diff, -jnp.inf))
        scores = jnp.einsum('bhtd,bhsd,bhtsd->bhts', qc, kc, decay)
        o = jnp.einsum('bhts,bhse->bhte', scores, vc) \
            + jnp.einsum('bhtd,bhde->bhte', qc * jnp.exp(b), state)
        b_last = b[..., -1:, :]
        state = jnp.swapaxes(jnp.exp(b_last), -1, -2) * state \
            + jnp.einsum('bhsd,bhse->bhde', kc * jnp.exp(b_last - b), vc)
        return state, o

    state0 = jnp.zeros((B, H, dk, dv), jnp.float32)
    _, o = lax.scan(step, state0, (chunks(q), chunks(k), chunks(v), chunks(log_a)))
    return o.transpose(1, 0, 3, 2, 4).reshape(B, S, H, dv)


def banded_causal_attention(q, k, v, span):
    L, hd = q.shape[-2], q.shape[-1]
    nb = -(-L // BAND_BLOCK)
    lp = nb * BAND_BLOCK
    n_prev = -(-span // BAND_BLOCK)
    lead = [(0, 0)] * (q.ndim - 2)
    qb = jnp.pad(q, lead + [(0, lp - L), (0, 0)]).reshape(*q.shape[:-2], nb, BAND_BLOCK, hd)

    def with_history(t):
        t = jnp.pad(t, lead + [(n_prev * BAND_BLOCK, lp - L), (0, 0)])
        t = t.reshape(*t.shape[:-2], nb + n_prev, BAND_BLOCK, hd)
        return jnp.concatenate([t[..., j:j + nb, :, :] for j in range(n_prev + 1)], axis=-2)

    kb, vb = with_history(k), with_history(v)
    kw = (n_prev + 1) * BAND_BLOCK
    i = jnp.arange(BAND_BLOCK)[None, :, None]
    m = jnp.arange(kw)[None, None, :]
    blk = jnp.arange(nb)[:, None, None]
    dist = i + n_prev * BAND_BLOCK - m
    key_pos = (blk - n_prev) * BAND_BLOCK + m
    mask = (dist >= 0) & (dist <= span) & (key_pos >= 0)

    s = jnp.einsum('...nid,...nmd->...nim', qb.astype(jnp.float32), kb.astype(jnp.float32))
    s = jnp.where(mask, s, -jnp.inf)
    lse = jax.nn.logsumexp(s, axis=-1)
    p = jnp.exp(s - lse[..., None])
    o = jnp.einsum('...nim,...nmd->...nid', p, vb.astype(jnp.float32))
    o = o.reshape(*q.shape[:-2], lp, hd)[..., :L, :]
    lse = lse.reshape(*q.shape[:-2], lp)[..., :L]
    return o, lse


def dilated_attention(q, k, v):
    B, H, S, hd = q.shape
    q = q * (hd ** -0.5)
    outs, lses = [], []
    for window, dil in DILATED_BRANCHES:
        def to_sub(t):
            return jnp.swapaxes(t.reshape(B, H, S // dil, dil, hd), 2, 3)
        o, lse = banded_causal_attention(to_sub(q), to_sub(k), to_sub(v), window // dil)
        outs.append(jnp.swapaxes(o, 2, 3).reshape(B, H, S, hd))
        lses.append(jnp.swapaxes(lse, 2, 3).reshape(B, H, S))
    w = jax.nn.softmax(jnp.stack(lses, axis=0), axis=0)
    return jnp.einsum('rbhs,rbhsd->bhsd', w, jnp.stack(outs, axis=0))


def token_mixer(u, positions, w_in, w_gla_gate, b_gla_gate, gla_norm_g, w_out):
    B, S, _ = u.shape
    proj = u @ w_in
    gq, gk, gv, gr, glr, aq, ak, av = split_sizes(proj, IN_SIZES)
    f32 = jnp.float32
    q_g = gq.astype(f32).reshape(B, S, GLA_HEADS, GLA_DK) * (GLA_DK ** -0.5)
    k_g = gk.astype(f32).reshape(B, S, GLA_HEADS, GLA_DK)
    v_g = gv.astype(f32).reshape(B, S, GLA_HEADS, GLA_DV)
    gate_logits = glr.astype(f32) @ w_gla_gate.astype(f32) + b_gla_gate.astype(f32)
    log_a = (jax.nn.log_sigmoid(gate_logits) / GLA_TAU).reshape(B, S, GLA_HEADS, GLA_DK)
    o_g = gla_chunked(q_g, k_g, v_g, log_a)
    o_g = o_g * lax.rsqrt(jnp.mean(jnp.square(o_g), axis=-1, keepdims=True) + RMS_EPS) \
        * gla_norm_g.astype(f32)
    o_g = (o_g.reshape(B, S, GLA_WIDTH) * jax.nn.silu(gr.astype(f32))).astype(u.dtype)
    q_a = rotary(aq.reshape(B, S, ATT_HEADS, ATT_HD), positions)
    k_a = rotary(ak.reshape(B, S, ATT_HEADS, ATT_HD), positions)
    v_a = av.reshape(B, S, ATT_HEADS, ATT_HD)
    o_a = dilated_attention(jnp.swapaxes(q_a, 1, 2), jnp.swapaxes(k_a, 1, 2), jnp.swapaxes(v_a, 1, 2))
    o_a = jnp.swapaxes(o_a, 1, 2).reshape(B, S, ATT_WIDTH).astype(u.dtype)
    return jnp.concatenate([o_g, o_a], axis=-1) @ w_out


def conv_ffn(u, w_up, conv_w, conv_b, w_down):
    S = u.shape[1]
    h = u @ w_up
    hp = jnp.pad(h, ((0, 0), (CONV_WIDTH - 1, 0), (0, 0)))
    y = conv_b
    for j in range(CONV_WIDTH):
        y = y + conv_w[j] * hp[:, j:j + S, :]
    a, g = jnp.split(y, 2, axis=-1)
    return (jax.nn.silu(g) * a) @ w_down


def setup_inputs(seed: int = 0) -> dict:
    key = jax.random.key(seed)
    ks = jax.random.split(key, 20)
    f32 = jnp.float32
    x = jax.random.normal(ks[0], (BATCH, SEQ, D_MODEL), f32)
    c = jax.random.normal(ks[1], (BATCH, D_MODEL), f32)
    positions = (jax.random.randint(ks[2], (BATCH, 1), 0, MAX_POS_OFFSET)
                 + jnp.arange(SEQ)[None, :]).astype(jnp.int32)
    w_ada = jax.random.normal(ks[3], (DEPTH, D_MODEL, 6 * D_MODEL), f32) * ADA_STD
    b_ada = jax.random.normal(ks[4], (DEPTH, 6 * D_MODEL), f32) * 0.01
    col_scale = jnp.concatenate([jnp.full((n,), DEEPNORM_BETA if is_v else 1.0, f32)
                                 for n, is_v in zip(IN_SIZES, IN_IS_VALUE)])
    w_in = jax.random.normal(ks[5], (DEPTH, D_MODEL, IN_COLS), f32) * (D_MODEL ** -0.5) * col_scale
    w_gla_gate = jax.random.normal(ks[6], (DEPTH, GLA_GATE_RANK, GLA_HEADS * GLA_DK), f32) * (GLA_GATE_RANK ** -0.5)
    b_gla_gate = jax.random.normal(ks[7], (DEPTH, GLA_HEADS * GLA_DK), f32) * 0.1
    gla_norm_g = 1.0 + 0.02 * jax.random.normal(ks[8], (DEPTH, GLA_DV), f32)
    w_out = jax.random.normal(ks[9], (DEPTH, D_MODEL, D_MODEL), f32) * (D_MODEL ** -0.5) * DEEPNORM_BETA
    ln1_g = 1.0 + 0.02 * jax.random.normal(ks[10], (DEPTH, D_MODEL), f32)
    ln1_b = 0.02 * jax.random.normal(ks[11], (DEPTH, D_MODEL), f32)
    w_up = jax.random.normal(ks[12], (DEPTH, D_MODEL, 2 * D_FF), f32) * (D_MODEL ** -0.5) * DEEPNORM_BETA
    conv_w = jax.random.normal(ks[13], (DEPTH, CONV_WIDTH, 2 * D_FF), f32) * (CONV_WIDTH ** -0.5)
    conv_b = 0.01 * jax.random.normal(ks[14], (DEPTH, 2 * D_FF), f32)
    w_down = jax.random.normal(ks[15], (DEPTH, D_FF, D_MODEL), f32) * (D_FF ** -0.5) * DEEPNORM_BETA
    ln2_g = 1.0 + 0.02 * jax.random.normal(ks[16], (DEPTH, D_MODEL), f32)
    ln2_b = 0.02 * jax.random.normal(ks[17], (DEPTH, D_MODEL), f32)
    return {"x": x, "c": c, "positions": positions, "w_ada": w_ada, "b_ada": b_ada,
            "w_in": w_in, "w_gla_gate": w_gla_gate, "b_gla_gate": b_gla_gate,
            "gla_norm_g": gla_norm_g, "w_out": w_out, "ln1_g": ln1_g, "ln1_b": ln1_b,
            "w_up": w_up, "conv_w": conv_w, "conv_b": conv_b, "w_down": w_down,
            "ln2_g": ln2_g, "ln2_b": ln2_b}


def reference(x, c, positions, w_ada, b_ada, w_in, w_gla_gate, b_gla_gate, gla_norm_g, w_out,
              ln1_g, ln1_b, w_up, conv_w, conv_b, w_down, ln2_g, ln2_b):
    for layer in range(DEPTH):
        mod = jax.nn.silu(c) @ w_ada[layer] + b_ada[layer]
        sh1, sc1, g1, sh2, sc2, g2 = [m[:, None, :] for m in jnp.split(mod, 6, axis=-1)]
        u = x * (1.0 + sc1) + sh1
        y = token_mixer(u, positions, w_in[layer], w_gla_gate[layer], b_gla_gate[layer],
                        gla_norm_g[layer], w_out[layer])
        x = layer_norm(DEEPNORM_ALPHA * x + (1.0 + g1) * y, ln1_g[layer], ln1_b[layer])
        u = x * (1.0 + sc2) + sh2
        y = conv_ffn(u, w_up[layer], conv_w[layer], conv_b[layer], w_down[layer])
        x = layer_norm(DEEPNORM_ALPHA * x + (1.0 + g2) * y, ln2_g[layer], ln2_b[layer])
    return x
```

```cpp
#include <hip/hip_runtime.h>
#include <hip/hip_cooperative_groups.h>
#include <cstdio>
#include <cstdint>
namespace cg = cooperative_groups;
namespace pg8 {
#define PG8_LAS __attribute__((address_space(3)))
typedef unsigned short bf16_t;
typedef short bf16x8 __attribute__((ext_vector_type(8)));
typedef float f32x4 __attribute__((ext_vector_type(4)));
typedef unsigned u32x4 __attribute__((ext_vector_type(4)));
constexpr int BM = 256, BK = 64, HALF = 128, HTB = HALF * BK * 2  , STAGE_BYTES = 8 * HTB, NXCD = 8, WGM = 8;

__host__ __device__ __forceinline__ int lds_byte(int r, int c) { const int st = (r >> 4) * 2 + (c >> 5), rr = r & 15, cc = c & 31, ob = rr * 64 + cc * 2; return st * 1024 + (ob ^ (((ob >> 9) & 1) << 5)); }
__host__ __device__ __forceinline__ void stage_rc(int b, int& R, int& C) { const int st = b / 1024, sb = b % 1024, swz = sb ^ (((sb >> 9) & 1) << 5); R = (st >> 1) * 16 + swz / 64; C = (st & 1) * 32 + (swz % 64) / 2; }
__host__ __device__ __forceinline__ int perm32(int rho) { const int n = rho >> 4, i = rho & 15; return 8 * (i >> 2) + 4 * n + (i & 3); }

struct Unit { int pm, pn; };
struct Gemm { const bf16_t* A; const bf16_t* Bt; int M, N, K; };

struct StaticOrder {
    int nM, nN, nwg, G, c;
    __host__ __device__ void init(int M, int N, int G_, int c_) { nM = M / BM; nN = N / BM; nwg = nM * nN; G = G_; c = c_; }
    __host__ __device__ bool next(int i, Unit& u) const {
        const long L = (long)i * G + c; if (L >= nwg) return false;
        int wgid = (int)L; { const int q = nwg / NXCD, r = nwg % NXCD, xcd = wgid % NXCD, off = wgid / NXCD; wgid = (xcd < r ? xcd * (q + 1) : r * (q + 1) + (xcd - r) * q) + off; }
        const int nig = WGM * nN, gid = wgid / nig, fm = gid * WGM, gsz = (nM - fm) < WGM ? (nM - fm) : WGM;
        u.pm = fm + ((wgid % nig) % gsz); u.pn = (wgid % nig) / gsz; return true;
    }
    __device__ __forceinline__ void a_ready(const Unit&) const {}
    __device__ __forceinline__ void done(const Unit&) const {}
};

__device__ __forceinline__ unsigned cvt_pk_bf16(float lo, float hi) { unsigned r; asm volatile("v_cvt_pk_bf16_f32 %0, %1, %2" : "=v"(r) : "v"(lo), "v"(hi)); return r; }
typedef float f32x2 __attribute__((ext_vector_type(2)));
struct EpiBf16 {
    static constexpr bool PERM = true, AFTER_DRAIN = false;
    bf16_t* O; int ldc; unsigned scale_mask; float scale;
    __device__ __forceinline__ void operator()(const f32x4 (&acc)[2][2][4][2], const Unit& u, int wr, int wc, int fr, int fq) const {
        const int row0 = u.pm * BM + wr * 64 + fr; const int colt = u.pn * BM;
        const float sc = ((scale_mask >> u.pn) & 1u) ? scale : 1.f;
        const int col0 = colt + wc * 32 + 8 * fq;
#pragma unroll
        for (int ai = 0; ai < 2; ++ai)
#pragma unroll
            for (int m = 0; m < 4; ++m) { bf16_t* rowp = O + (size_t)(row0 + ai * HALF + m * 16) * ldc + col0;
#pragma unroll
                for (int bj = 0; bj < 2; ++bj) { f32x4 v0 = acc[ai][bj][m][0] * sc, v1 = acc[ai][bj][m][1] * sc;
                    u32x4 w; w.x = cvt_pk_bf16(v0[0], v0[1]); w.y = cvt_pk_bf16(v0[2], v0[3]); w.z = cvt_pk_bf16(v1[0], v1[1]); w.w = cvt_pk_bf16(v1[2], v1[3]);
                    *(u32x4*)(rowp + bj * HALF) = w; } }
    }
};
struct EpiResid {
    static constexpr bool PERM = false, AFTER_DRAIN = false;
    const float* base; float* out; int ldc; const float* gate; float alpha;
    __device__ __forceinline__ void operator()(const f32x4 (&acc)[2][2][4][2], const Unit& u, int wr, int wc, int fr, int fq) const {
        const int col0 = u.pn * BM + wc * 32 + 4 * fq;
        f32x4 gv[2][2];
#pragma unroll
        for (int bj = 0; bj < 2; ++bj)
#pragma unroll
            for (int n = 0; n < 2; ++n) gv[bj][n] = *(const f32x4*)(gate + col0 + bj * HALF + n * 16) + 1.0f;
#pragma unroll
        for (int ai = 0; ai < 2; ++ai)
#pragma unroll
            for (int m = 0; m < 4; ++m) { const size_t off = (size_t)(u.pm * BM + ai * HALF + wr * 64 + m * 16 + fr) * ldc + col0;
#pragma unroll
                for (int bj = 0; bj < 2; ++bj)
#pragma unroll
                    for (int n = 0; n < 2; ++n) { const f32x4 bs = *(const f32x4*)(base + off + bj * HALF + n * 16);
                        *(f32x4*)(out + off + bj * HALF + n * 16) = bs * alpha + gv[bj][n] * acc[ai][bj][m][n]; } }
    }
};
template <class Epi, class Sched, bool ALIGN_EPI = false, bool SP2 = false>
__device__ __forceinline__ void gemm_phase(PG8_LAS unsigned char* lds, const Gemm g, const Sched& S, const Epi& E) {
    const int tid = threadIdx.x, wid = __builtin_amdgcn_readfirstlane(tid >> 6), lane = tid & 63, wr = wid >> 2, wc = wid & 3, fr = lane & 15, fq = lane >> 4;
    const int K = g.K, nt = K / BK;
    unsigned voffA[2], voffB[2];
#pragma unroll
    for (int i = 0; i < 2; ++i) { int R, C; stage_rc(tid * 16 + i * 8192, R, C); const int Rb = Epi::PERM ? ((R & ~31) + perm32(R & 31)) : R;
        voffA[i] = (unsigned)(R * K + C) * 2u; voffB[i] = (unsigned)(Rb * K + C) * 2u; }
    const size_t kstep = (size_t)(BK * 2);
    const size_t hstep = (size_t)HALF * K * 2;
    const size_t tstep = 2 * hstep;
    const unsigned ldsw = (unsigned)wid * 1024u;
    const int aoff = lds_byte(wr * 64 + fr, fq * 8), boff = lds_byte(wc * 32 + fr, fq * 8);
#define PG8_SA(b, h) (((b) * 2 + (h)) * HTB)
#define PG8_SB(b, h) ((4 + (b) * 2 + (h)) * HTB)
#define PG8_STAGE(bufoff, gbase, voff) do { _Pragma("unroll") for (int _i = 0; _i < 2; ++_i) \
        __builtin_amdgcn_global_load_lds((const unsigned*)((const char*)(gbase) + (voff)[_i]), (PG8_LAS unsigned*)(lds + (bufoff) + ldsw + _i * 8192), 16, 0, 0); } while (0)
#define PG8_LDA(dst, b, h) do { _Pragma("unroll") for (int m = 0; m < 4; ++m) _Pragma("unroll") for (int k = 0; k < 2; ++k) dst[m][k] = *(const PG8_LAS bf16x8*)(lds + PG8_SA(b, h) + aoff + m * 2048 + k * 1024); } while (0)
#define PG8_LDB(dst, b, h) do { _Pragma("unroll") for (int n = 0; n < 2; ++n) _Pragma("unroll") for (int k = 0; k < 2; ++k) dst[n][k] = *(const PG8_LAS bf16x8*)(lds + PG8_SB(b, h) + boff + n * 2048 + k * 1024); } while (0)
#define PG8_MMA(ai, bj, At, Bt) do { __builtin_amdgcn_s_setprio(1); _Pragma("unroll") for (int m = 0; m < 4; ++m) _Pragma("unroll") for (int n = 0; n < 2; ++n) _Pragma("unroll") for (int k = 0; k < 2; ++k) \
        acc[ai][bj][m][n] = __builtin_amdgcn_mfma_f32_16x16x32_bf16(Bt[n][k], At[m][k], acc[ai][bj][m][n], 0, 0, 0); __builtin_amdgcn_s_setprio(0); } while (0)
#define PG8_WAIT_V(n) asm volatile("s_waitcnt vmcnt(" #n ")" ::: "memory")
#define PG8_WAIT_L(n) asm volatile("s_waitcnt lgkmcnt(" #n ")" ::: "memory")
#define PG8_BAR __builtin_amdgcn_s_barrier()
#define PG8_SCHED __builtin_amdgcn_sched_barrier(0)
    Unit cur, nxt; int ui = 0;
    if (!S.next(0, cur)) return;
    f32x4 acc[2][2][4][2];
#pragma unroll
    for (int a = 0; a < 2; ++a)
#pragma unroll
        for (int b = 0; b < 2; ++b)
#pragma unroll
            for (int m = 0; m < 4; ++m)
#pragma unroll
                for (int n = 0; n < 2; ++n) acc[a][b][m][n] = (f32x4){0.f, 0.f, 0.f, 0.f};
    bf16x8 At[4][2], B0[2][2], B1[2][2];
    const char* cA = (const char*)g.A + (size_t)cur.pm * tstep; const char* cB = (const char*)g.Bt + (size_t)cur.pn * tstep;
    S.a_ready(cur);
    if constexpr (SP2) {
        PG8_STAGE(PG8_SB(0, 0), cB, voffB); PG8_STAGE(PG8_SB(0, 1), cB + hstep, voffB); PG8_STAGE(PG8_SA(0, 0), cA, voffA); PG8_STAGE(PG8_SA(0, 1), cA + hstep, voffA);
        if (wr == 1) PG8_BAR;
        PG8_WAIT_V(2); PG8_BAR;
        PG8_STAGE(PG8_SB(1, 0), cB + kstep, voffB); PG8_STAGE(PG8_SA(1, 0), cA + kstep, voffA); PG8_STAGE(PG8_SB(1, 1), cB + hstep + kstep, voffB);
        PG8_WAIT_V(6); PG8_BAR;
    } else {
        PG8_STAGE(PG8_SB(0, 0), cB, voffB); PG8_STAGE(PG8_SA(0, 0), cA, voffA); PG8_STAGE(PG8_SB(0, 1), cB + hstep, voffB); PG8_STAGE(PG8_SA(0, 1), cA + hstep, voffA);
        if (wr == 1) PG8_BAR;
        PG8_WAIT_V(4); PG8_BAR;
        PG8_STAGE(PG8_SB(1, 0), cB + kstep, voffB); PG8_STAGE(PG8_SA(1, 0), cA + kstep, voffA); PG8_STAGE(PG8_SB(1, 1), cB + hstep + kstep, voffB);
        PG8_WAIT_V(6); PG8_BAR;
    }
    for (;;) {
        const bool has_next = S.next(ui + 1, nxt);
        const char* nA = has_next ? (const char*)g.A + (size_t)nxt.pm * tstep : cA; const char* nB = has_next ? (const char*)g.Bt + (size_t)nxt.pn * tstep : cB;
        for (int t = 0; t < nt; t += 2) {
            const bool last = (t == nt - 2);
            const char* a1 = cA + (size_t)(t + 1) * kstep;
            const char* a2 = last ? nA : cA + (size_t)(t + 2) * kstep; const char* b2 = last ? nB : cB + (size_t)(t + 2) * kstep;
            const char* a3 = a2 + kstep; const char* b3 = b2 + kstep;
            if (last && has_next) S.a_ready(nxt);
            if constexpr (SP2) {
            PG8_LDB(B0, 0, 0); PG8_LDB(B1, 0, 1); PG8_SCHED; PG8_LDA(At, 0, 0); PG8_STAGE(PG8_SA(1, 1), a1 + hstep, voffA);
            PG8_WAIT_V(8); PG8_WAIT_L(0); PG8_BAR; PG8_MMA(0, 0, At, B0); PG8_MMA(0, 1, At, B1); PG8_BAR; PG8_SCHED;
            PG8_LDA(At, 0, 1); PG8_STAGE(PG8_SB(0, 0), b2, voffB); PG8_STAGE(PG8_SB(0, 1), b2 + hstep, voffB); PG8_STAGE(PG8_SA(0, 0), a2, voffA);
            PG8_WAIT_V(8); PG8_WAIT_L(0); PG8_BAR; PG8_MMA(1, 0, At, B0); PG8_MMA(1, 1, At, B1); PG8_BAR; PG8_SCHED;
            PG8_LDB(B0, 1, 0); PG8_LDB(B1, 1, 1); PG8_SCHED; PG8_LDA(At, 1, 0); PG8_STAGE(PG8_SA(0, 1), a2 + hstep, voffA);
            PG8_WAIT_V(8); PG8_WAIT_L(0); PG8_BAR; PG8_MMA(0, 0, At, B0); PG8_MMA(0, 1, At, B1); PG8_BAR; PG8_SCHED;
            PG8_LDA(At, 1, 1); PG8_STAGE(PG8_SB(1, 0), b3, voffB); PG8_STAGE(PG8_SB(1, 1), b3 + hstep, voffB); PG8_STAGE(PG8_SA(1, 0), a3, voffA);
            PG8_WAIT_V(8); PG8_WAIT_L(0); PG8_BAR; PG8_MMA(1, 0, At, B0); PG8_MMA(1, 1, At, B1); PG8_BAR; PG8_SCHED;
            } else {
            PG8_LDB(B0, 0, 0); PG8_SCHED; PG8_LDA(At, 0, 0); PG8_STAGE(PG8_SA(1, 1), a1 + hstep, voffA);
            PG8_WAIT_L(8); PG8_BAR; PG8_WAIT_L(0); PG8_MMA(0, 0, At, B0); PG8_BAR; PG8_SCHED;
            PG8_LDB(B1, 0, 1); PG8_STAGE(PG8_SB(0, 0), b2, voffB);
            PG8_BAR; PG8_WAIT_L(0); PG8_MMA(0, 1, At, B1); PG8_BAR;
            PG8_LDA(At, 0, 1); PG8_STAGE(PG8_SA(0, 0), a2, voffA);
            PG8_BAR; PG8_WAIT_L(0); PG8_MMA(1, 0, At, B0); PG8_BAR; PG8_SCHED;
            PG8_STAGE(PG8_SB(0, 1), b2 + hstep, voffB);
            PG8_WAIT_V(6); PG8_BAR; PG8_MMA(1, 1, At, B1); PG8_BAR;
            PG8_LDB(B0, 1, 0); PG8_SCHED; PG8_LDA(At, 1, 0); PG8_STAGE(PG8_SA(0, 1), a2 + hstep, voffA);
            PG8_WAIT_L(8); PG8_BAR; PG8_WAIT_L(0); PG8_MMA(0, 0, At, B0); PG8_BAR; PG8_SCHED;
            PG8_LDB(B1, 1, 1); PG8_STAGE(PG8_SB(1, 0), b3, voffB);
            PG8_BAR; PG8_WAIT_L(0); PG8_MMA(0, 1, At, B1); PG8_BAR;
            PG8_LDA(At, 1, 1); PG8_STAGE(PG8_SA(1, 0), a3, voffA);
            PG8_BAR; PG8_WAIT_L(0); PG8_MMA(1, 0, At, B0); PG8_BAR; PG8_SCHED;
            PG8_STAGE(PG8_SB(1, 1), b3 + hstep, voffB);
            PG8_WAIT_V(6); PG8_BAR; PG8_MMA(1, 1, At, B1); PG8_BAR;
            }
        }
        if constexpr (ALIGN_EPI) { if (wr == 0) PG8_BAR; }
        if constexpr (!Epi::AFTER_DRAIN) { E(acc, cur, wr, wc, fr, fq); S.done(cur); }
        if (!has_next) break;
#pragma unroll
        for (int a = 0; a < 2; ++a)
#pragma unroll
            for (int b = 0; b < 2; ++b)
#pragma unroll
                for (int m = 0; m < 4; ++m)
#pragma unroll
                    for (int n = 0; n < 2; ++n) acc[a][b][m][n] = (f32x4){0.f, 0.f, 0.f, 0.f};
        cur = nxt; cA = nA; cB = nB; ++ui;
        if constexpr (ALIGN_EPI) { if (wr == 1) PG8_BAR; }
    }
    PG8_WAIT_V(0);
    if constexpr (!ALIGN_EPI) { if (wr == 0) PG8_BAR; }
    PG8_BAR;
    if constexpr (Epi::AFTER_DRAIN) { E.fused(acc, cur, wr, wc, fr, fq, lds, wid, lane); S.done(cur); }
#undef PG8_SA
#undef PG8_SB
#undef PG8_STAGE
#undef PG8_LDA
#undef PG8_LDB
#undef PG8_MMA
#undef PG8_WAIT_V
#undef PG8_WAIT_L
#undef PG8_BAR
#undef PG8_SCHED
}
}
#define GAS __attribute__((address_space(1)))
#define LAS __attribute__((address_space(3)))
typedef unsigned short bf16;
typedef unsigned v4u __attribute__((ext_vector_type(4)));
typedef float f32x4 __attribute__((ext_vector_type(4)));
typedef short bf16x8 __attribute__((ext_vector_type(8)));
typedef GAS unsigned gu32;
typedef GAS unsigned long long gu64;
#define RLX_AGENT __ATOMIC_RELAXED, __HIP_MEMORY_SCOPE_AGENT
#define LDS_WAIT() asm volatile("s_waitcnt lgkmcnt(0)" ::: "memory")
#define VM_WAIT() asm volatile("s_waitcnt vmcnt(0)" ::: "memory")
__device__ __forceinline__ unsigned long long rt() { return __builtin_amdgcn_s_memrealtime(); }
__device__ __forceinline__ unsigned f2bf(float f) { unsigned u = __builtin_bit_cast(unsigned, f); return (u + 0x7fffu + ((u >> 16) & 1u)) >> 16; }
__device__ __forceinline__ unsigned pk2(float lo, float hi) { return f2bf(lo) | (f2bf(hi) << 16); }

#define XB_TMO      128
#define XB_XCNT(j)  (256  + 64 * (j))
#define XB_XSUB(j)  (1280 + 64 * (j))
#define XB_XGEN(j)  (2304 + 64 * (j))
#define XB_TOP      3328
#define XB_TOPGEN   3392
#define XCD_BAR_WORDS 3456
#define XB_SPIN_CAP (1u << 18)

__device__ __forceinline__ unsigned xb_ld(unsigned* p)              { return __hip_atomic_load(p, __ATOMIC_RELAXED, __HIP_MEMORY_SCOPE_AGENT); }
__device__ __forceinline__ unsigned xb_add(unsigned* p, unsigned v) { return __hip_atomic_fetch_add(p, v, __ATOMIC_RELAXED, __HIP_MEMORY_SCOPE_AGENT); }
__device__ __forceinline__ unsigned xb_xcc_id() { return (unsigned)__builtin_amdgcn_s_getreg((3 << 11) | 20) & 0xFu; }
#define XB_SPIN(cond, bar) do { unsigned _sp = 0; while (cond) { __builtin_amdgcn_s_sleep(1); \
    if ((++_sp & 255u) == 0u) { if (xb_ld(&(bar)[XB_TMO])) break; if (_sp > XB_SPIN_CAP) { atomicAdd(&(bar)[XB_TMO], 1u); break; } } } } while (0)

struct XcdBarrier {
    unsigned* bar; unsigned x;
    volatile LAS unsigned* st;
};

__device__ __forceinline__ XcdBarrier xcd_barrier_post(unsigned* bar, volatile LAS unsigned* st) {
    XcdBarrier b; b.bar = bar; b.x = xb_xcc_id(); b.st = st;
    if (threadIdx.x == 0) (void)xb_add(&bar[XB_XCNT(b.x)], 1u);
    return b;
}
__device__ __forceinline__ void xcd_barrier_complete(unsigned* bar, unsigned x, unsigned& nloc, unsigned& nx) {
    const unsigned G = gridDim.x * gridDim.y * gridDim.z;
    unsigned sum, cnt, mine, sp = 0u;
    for (;;) {
        sum = 0u; cnt = 0u; mine = 0u;
#pragma unroll
        for (unsigned j = 0; j < 16; ++j) { const unsigned c = xb_ld(&bar[XB_XCNT(j)]); sum += c; cnt += (c > 0u) ? 1u : 0u; mine = (j == x) ? c : mine; }
        if (sum == G) break;
        __builtin_amdgcn_s_sleep(1);
        if ((++sp & 255u) == 0u) { if (xb_ld(&bar[XB_TMO])) break; if (sp > XB_SPIN_CAP) { atomicAdd(&bar[XB_TMO], 1u); break; } }
    }
    nloc = mine > 0u ? mine : 1u; nx = cnt > 0u ? cnt : 1u;
}

__device__ __forceinline__ void xcd_barrier(const XcdBarrier& b) {
    asm volatile("s_waitcnt vmcnt(0)" ::: "memory");
    __syncthreads();
    if (threadIdx.x == 0) {
        unsigned* bar = b.bar;
        __builtin_amdgcn_s_waitcnt(0);
        unsigned nloc = b.st[0], nx = b.st[1];
        if (nloc == 0u) { xcd_barrier_complete(bar, b.x, nloc, nx); b.st[0] = nloc; b.st[1] = nx; }
        const unsigned old = xb_add(&bar[XB_XSUB(b.x)], 1u);
        const unsigned gen = old / nloc;
        if (old + 1u == (gen + 1u) * nloc) {
            __builtin_amdgcn_fence(__ATOMIC_RELEASE, "agent");
            asm volatile("s_waitcnt vmcnt(0)" ::: "memory");
            const unsigned og = xb_add(&bar[XB_TOP], 1u);
            const unsigned tg = og / nx;
            if (og + 1u == (tg + 1u) * nx) xb_add(&bar[XB_TOPGEN], 1u);
            else XB_SPIN(xb_ld(&bar[XB_TOPGEN]) == tg, bar);
            __builtin_amdgcn_fence(__ATOMIC_ACQUIRE, "agent");
            xb_add(&bar[XB_XGEN(b.x)], 1u);
            asm volatile("s_waitcnt vmcnt(0)" ::: "memory");
        } else {
            XB_SPIN(xb_ld(&bar[XB_XGEN(b.x)]) == gen, bar);
            __builtin_amdgcn_fence(__ATOMIC_ACQUIRE, "agent");
            asm volatile("s_waitcnt vmcnt(0)" ::: "memory");
        }
    }
    __syncthreads();
}
constexpr int NWAVES = 8, NTHREADS = 512;
constexpr int DM = 2048, SEQ = 8192, DFF = 5632, NUP = 2 * DFF;
constexpr int NPROJ = 6144;
constexpr int C_GQ = 0, C_GK = 512, C_GV = 1024, C_GR = 2048, C_AQ = 3072, C_AK = 4096, C_AV = 5120;
constexpr int WIN_LD = 6160, LR_COL = 3072;
constexpr float ALPHA = 1.189207115002721f;
constexpr float LN_EPS = 1e-5f, RMS_EPS = 1e-6f;
constexpr float QSCALE = 0.08838834764831845f;

constexpr size_t MiB = 1u << 20;
constexpr size_t WS_CTL = 0, CTL_ZERO_BYTES = 1 * MiB;
constexpr size_t WS_WDOWN = 1 * MiB, WS_WIN = 23 * MiB, WS_WOUT = 47 * MiB, WS_WUP = 55 * MiB;
constexpr size_t WS_U = 99 * MiB, U_PAD_ROWS = 2, U_ROWS_ALLOC = 8320;
constexpr size_t WS_MISC = 132 * MiB;
constexpr size_t MISC_MODP = 0, MISC_MOD = 512 * 1024, MISC_GLR = 1 * MiB, MISC_WLR = 2 * MiB;
constexpr size_t WS_X1 = 136 * MiB;
constexpr size_t WS_PROJ = 200 * MiB, WS_LOGA = 296 * MiB, WS_OGRAW = 312 * MiB, WS_OCAT = 344 * MiB;
constexpr size_t WS_H = 200 * MiB;
constexpr size_t WS_ACT = 23 * MiB;
constexpr size_t WS_END = 384 * MiB;
constexpr int CW_BAR = 4096;

constexpr int LDS_BYTES = 147456;
constexpr int RING_BYTES = 131072, MISC_OFF = RING_BYTES + 320;

struct Args { const float* in[18]; float* out; unsigned char* ws; int ph_lo, ph_hi; };

struct Frame {
    LAS unsigned char* lds; int tid, lane, wave, G;
    const float *x, *c, *w_ada, *b_ada, *w_in, *w_gate, *b_gate, *gnorm, *w_out, *ln1g, *ln1b, *w_up, *conv_w, *conv_b, *w_down, *ln2g, *ln2b;
    const int* pos;
    float* out; unsigned char* ws;
    bf16 *WinT, *WoutT, *WupT, *WdownT, *U, *PROJ, *OCAT, *H, *ACT;
    float *MODP, *MOD, *GLR, *X1, *LOGA, *OGRAW;
};

__device__ __forceinline__ float bf2f(bf16 v) { return __builtin_bit_cast(float, (unsigned)v << 16); }
__device__ __forceinline__ float wave_sum(float v) {
#pragma unroll
    for (int o = 1; o < 64; o <<= 1) v += __shfl_xor(v, o);
    return v;
}
__device__ __forceinline__ float siluf(float v) { return v / (1.0f + __expf(-v)); }

__device__ __forceinline__ void transpose_item(const float* W, int ldn, int K, int k0, int srcn0, bf16* WT, int dstn0, LAS float* scr, int lane) {
#pragma unroll 8
    for (int i = 0; i < 32; ++i) { const int kk = 2 * i + (lane >> 5); scr[kk * 33 + (lane & 31)] = W[(size_t)(k0 + kk) * ldn + srcn0 + (lane & 31)]; }
    LDS_WAIT(); asm volatile("" ::: "memory");
    const int c = lane & 7;
#pragma unroll
    for (int j = 0; j < 4; ++j) { const int n = (lane >> 3) + 8 * j; const LAS float* s = scr + (8 * c) * 33 + n;
        v4u o; o.x = pk2(s[0 * 33], s[1 * 33]); o.y = pk2(s[2 * 33], s[3 * 33]); o.z = pk2(s[4 * 33], s[5 * 33]); o.w = pk2(s[6 * 33], s[7 * 33]);
        *(GAS v4u*)(WT + (size_t)(dstn0 + n) * K + k0 + 8 * c) = o; }
    LDS_WAIT(); asm volatile("" ::: "memory");
}
__device__ __forceinline__ void p0_prep(Frame& F) {
    LAS float* red = (LAS float*)F.lds;
    for (int it = blockIdx.x; it < 384; it += F.G) {
        const int cgp = it % 48, kg = it / 48;
        f32x4 acc = {0.f, 0.f, 0.f, 0.f};
        const float* wp = F.w_ada + (size_t)(kg * 256 + F.wave * 32) * 12288 + cgp * 256 + 4 * F.lane;
#pragma unroll 8
        for (int kk = 0; kk < 32; ++kk) { const float s = siluf(F.c[kg * 256 + F.wave * 32 + kk]); acc += *(const f32x4*)(wp + (size_t)kk * 12288) * s; }
        __syncthreads();
        *(LAS f32x4*)(red + F.wave * 256 + 4 * F.lane) = acc;
        __syncthreads();
        if (F.tid < 256) { float s = 0.f;
#pragma unroll
            for (int w = 0; w < 8; ++w) s += red[w * 256 + F.tid];
            F.MODP[kg * 12288 + cgp * 256 + F.tid] = s; }
    }
    __syncthreads();
    LAS float* scr = (LAS float*)(F.lds + F.wave * 16384);
    const int gw = blockIdx.x * NWAVES + F.wave, NGW = F.G * NWAVES;
    constexpr int I_IN = 32 * 192, I_OUT = 32 * 64, I_UP = 32 * 352, I_DN = 88 * 64, NITEMS = I_IN + I_OUT + I_UP + I_DN;
    for (int it = gw; it < NITEMS; it += NGW) {
        int r = it;
        if (r < I_IN) { const int kb = r / 192, db = r % 192; transpose_item(F.w_in, WIN_LD, DM, kb * 64, db * 32 + (db >= 96 ? 16 : 0), F.WinT, db * 32, scr, F.lane); continue; } r -= I_IN;
        if (r < I_OUT) { const int kb = r / 64, db = r % 64; transpose_item(F.w_out, DM, DM, kb * 64, db * 32, F.WoutT, db * 32, scr, F.lane); continue; } r -= I_OUT;
        if (r < I_UP) { const int kb = r / 352, db = r % 352; const int pn = db >> 3, half = (db >> 2) & 1, q = db & 3;
            transpose_item(F.w_up, NUP, DM, kb * 64, half * DFF + pn * 128 + q * 32, F.WupT, db * 32, scr, F.lane); continue; } r -= I_UP;
        { const int kb = r / 64, db = r % 64; transpose_item(F.w_down, DM, DFF, kb * 64, db * 32, F.WdownT, db * 32, scr, F.lane); }
    }
    { bf16* ub = F.U - U_PAD_ROWS * DM; const int gt = blockIdx.x * NTHREADS + F.tid, NT = F.G * NTHREADS;
      for (int i = gt; i < (int)U_PAD_ROWS * DM / 8; i += NT) ((GAS v4u*)ub)[i] = (v4u){0u, 0u, 0u, 0u};
      GAS v4u* tail = (GAS v4u*)(F.U + (size_t)SEQ * DM);
      for (int i = gt; i < (int)(U_ROWS_ALLOC - U_PAD_ROWS - SEQ) * DM / 8; i += NT) tail[i] = (v4u){0u, 0u, 0u, 0u}; }
}

__device__ __forceinline__ void p1_u(Frame& F) {
    LAS float* smod = (LAS float*)F.lds;
    for (int i = F.tid; i < 12288; i += NTHREADS) {
        float s = F.b_ada[i];
#pragma unroll
        for (int p = 0; p < 8; ++p) s += F.MODP[p * 12288 + i];
        if (i < 4096) smod[i] = s;
        if (blockIdx.x == 0) F.MOD[i] = s;
    }
    __syncthreads();
    const int gw = blockIdx.x * NWAVES + F.wave, NGW = F.G * NWAVES;
    for (int row = gw; row < SEQ; row += NGW) {
        const GAS f32x4* xr = (const GAS f32x4*)(F.x + (size_t)row * DM) + F.lane;
        GAS unsigned long long* o8 = (GAS unsigned long long*)(F.U + (size_t)row * DM) + F.lane;
        float g[16];
#pragma unroll
        for (int j = 0; j < 16; ++j) g[j] = 0.f;
#pragma unroll
        for (int j = 0; j < 8; ++j) {
            const f32x4 xv = xr[64 * j]; const int col = 4 * F.lane + 256 * j;
            const f32x4 sh = *(LAS f32x4*)(smod + col), sc = *(LAS f32x4*)(smod + 2048 + col);
            const f32x4 u = xv * (sc + 1.0f) + sh;
            o8[64 * j] = (unsigned long long)pk2(u.x, u.y) | ((unsigned long long)pk2(u.z, u.w) << 32);
#pragma unroll
            for (int e = 0; e < 4; ++e) { const float* wr = F.w_in + (size_t)(col + e) * WIN_LD + LR_COL;
#pragma unroll
                for (int q = 0; q < 4; ++q) { const f32x4 wv = *(const f32x4*)(wr + 4 * q); g[4 * q + 0] += u[e] * wv.x; g[4 * q + 1] += u[e] * wv.y; g[4 * q + 2] += u[e] * wv.z; g[4 * q + 3] += u[e] * wv.w; } }
        }
#pragma unroll
        for (int j = 0; j < 16; ++j) g[j] = wave_sum(g[j]);
        if (F.lane == 0) {
#pragma unroll
            for (int j = 0; j < 16; ++j) F.GLR[row * 16 + j] = g[j]; }
    }
}

__device__ __forceinline__ void p3_naive(Frame& F) {
    const int gt = blockIdx.x * NTHREADS + F.tid, NT = F.G * NTHREADS;
    for (int idx = gt; idx < SEQ * 512; idx += NT) {
        const int t = idx >> 9, cc = idx & 511; float z = F.b_gate[cc];
#pragma unroll
        for (int j = 0; j < 16; ++j) z += F.GLR[t * 16 + j] * F.w_gate[j * 512 + cc];
        const float ls = fminf(z, 0.f) - log1pf(expf(-fabsf(z)));
        F.LOGA[idx] = ls * (1.0f / 16.0f);
    }
    for (int idx = gt; idx < SEQ * 2 * 8 * 64; idx += NT) {
        const int i = idx & 63, h = (idx >> 6) & 7, which = (idx >> 9) & 1, t = idx >> 10;
        bf16* p = F.PROJ + (size_t)t * NPROJ + (which ? C_AK : C_AQ) + h * 128 + i;
        const float a = bf2f(p[0]), b = bf2f(p[64]);
        const float inv_freq = powf(10000.0f, -(float)i / 64.0f);
        const float ang = (float)F.pos[t] * inv_freq; float sn, cs; sincosf(ang, &sn, &cs);
        const float sc = which ? 1.0f : QSCALE;
        p[0] = (bf16)f2bf((a * cs - b * sn) * sc); p[64] = (bf16)f2bf((b * cs + a * sn) * sc);
    }
}

__device__ __forceinline__ void p4_naive(Frame& F) {
    if (blockIdx.x < 2) {
        LAS float* sq = (LAS float*)F.lds; LAS float* sk = sq + 4096; LAS float* sa = sk + 4096;
        const int hh = F.tid >> 8, h = blockIdx.x * 2 + hh, e = F.tid & 255;
        float St[128];
#pragma unroll
        for (int d = 0; d < 128; ++d) St[d] = 0.f;
        for (int t0 = 0; t0 < SEQ; t0 += 16) {
            __syncthreads();
            for (int i = F.tid; i < 4096; i += NTHREADS) { const int h2 = i >> 11, tt = (i >> 7) & 15, d = i & 127, head = blockIdx.x * 2 + h2; const size_t row = t0 + tt;
                sq[i] = bf2f(F.PROJ[row * NPROJ + C_GQ + head * 128 + d]) * QSCALE;
                sk[i] = bf2f(F.PROJ[row * NPROJ + C_GK + head * 128 + d]);
                sa[i] = expf(F.LOGA[row * 512 + head * 128 + d]); }
            __syncthreads();
            for (int tt = 0; tt < 16; ++tt) {
                const float v = bf2f(F.PROJ[(size_t)(t0 + tt) * NPROJ + C_GV + h * 256 + e]); float o = 0.f; const int base = (hh * 16 + tt) * 128;
#pragma unroll
                for (int d = 0; d < 128; ++d) { St[d] = sa[base + d] * St[d] + sk[base + d] * v; o += sq[base + d] * St[d]; }
                F.OGRAW[(size_t)(t0 + tt) * 1024 + h * 256 + e] = o;
            }
        }
    } else {
        LAS float* sc = (LAS float*)(F.lds + F.wave * 2048);
        const int gw = (blockIdx.x - 2) * NWAVES + F.wave, NGW = (F.G - 2) * NWAVES, l = F.lane;
        for (int item = gw; item < SEQ * 8; item += NGW) {
            const int t = item >> 3, h = item & 7;
            const unsigned qq = *(const unsigned*)(F.PROJ + (size_t)t * NPROJ + C_AQ + h * 128 + 2 * l);
            const float q0 = __builtin_bit_cast(float, qq << 16), q1 = __builtin_bit_cast(float, qq & 0xffff0000u);
            float m = -INFINITY;
            for (int b = 0; b < 3; ++b) { const int r = b == 0 ? 1 : (b == 1 ? 4 : 16); const int jmax = min(128, t / r);
                for (int j = 0; j <= jmax; ++j) { const int s = t - j * r;
                    const unsigned kk = *(const unsigned*)(F.PROJ + (size_t)s * NPROJ + C_AK + h * 128 + 2 * l);
                    float p = q0 * __builtin_bit_cast(float, kk << 16) + q1 * __builtin_bit_cast(float, kk & 0xffff0000u);
                    p = wave_sum(p); m = fmaxf(m, p); if (l == 0) sc[b * 129 + j] = p; }
                if (l == 0) for (int j = jmax + 1; j <= 128; ++j) sc[b * 129 + j] = -INFINITY; }
            LDS_WAIT(); asm volatile("" ::: "memory");
            float lsum = 0.f, o0 = 0.f, o1 = 0.f;
            for (int b = 0; b < 3; ++b) { const int r = b == 0 ? 1 : (b == 1 ? 4 : 16); const int jmax = min(128, t / r);
                for (int j = 0; j <= jmax; ++j) { const int s = t - j * r; const float w = expf(sc[b * 129 + j] - m); lsum += w;
                    const unsigned vv = *(const unsigned*)(F.PROJ + (size_t)s * NPROJ + C_AV + h * 128 + 2 * l);
                    o0 += w * __builtin_bit_cast(float, vv << 16); o1 += w * __builtin_bit_cast(float, vv & 0xffff0000u); } }
            const float inv = 1.0f / lsum;
            *(unsigned*)(F.OCAT + (size_t)t * DM + 1024 + h * 128 + 2 * l) = pk2(o0 * inv, o1 * inv);
            LDS_WAIT(); asm volatile("" ::: "memory");
        }
    }
}

__device__ __forceinline__ void p5_glapost(Frame& F) {
    const int gw = blockIdx.x * NWAVES + F.wave, NGW = F.G * NWAVES, l = F.lane;
    for (int item = gw; item < SEQ * 4; item += NGW) {
        const int t = item >> 2, h = item & 3;
        const f32x4 o = *(const f32x4*)(F.OGRAW + (size_t)t * 1024 + h * 256 + 4 * l);
        const float ms = wave_sum(o.x * o.x + o.y * o.y + o.z * o.z + o.w * o.w) * (1.0f / 256.0f);
        const float r = 1.0f / sqrtf(ms + RMS_EPS);
        const f32x4 gn = *(const f32x4*)(F.gnorm + 4 * l);
        const bf16* gr = F.PROJ + (size_t)t * NPROJ + C_GR + h * 256 + 4 * l;
        const float r0 = o.x * r * gn.x * siluf(bf2f(gr[0])), r1 = o.y * r * gn.y * siluf(bf2f(gr[1])), r2 = o.z * r * gn.z * siluf(bf2f(gr[2])), r3 = o.w * r * gn.w * siluf(bf2f(gr[3]));
        *(unsigned long long*)(F.OCAT + (size_t)t * DM + h * 256 + 4 * l) = (unsigned long long)pk2(r0, r1) | ((unsigned long long)pk2(r2, r3) << 32);
    }
}

template <bool WRITE_U> __device__ __forceinline__ void ln_rows(Frame& F, const float* zin, float* xout, const float* g, const float* b, const float* sh, const float* sc) {
    const int gw = blockIdx.x * NWAVES + F.wave, NGW = F.G * NWAVES;
    for (int row = gw; row < SEQ; row += NGW) {
        const GAS f32x4* zr = (const GAS f32x4*)(zin + (size_t)row * DM) + F.lane;
        f32x4 v[8]; float s = 0.f;
#pragma unroll
        for (int j = 0; j < 8; ++j) { v[j] = zr[64 * j]; s += (v[j].x + v[j].y) + (v[j].z + v[j].w); }
        const float mean = wave_sum(s) * (1.0f / DM); float s2 = 0.f;
#pragma unroll
        for (int j = 0; j < 8; ++j) { v[j] = v[j] - mean; s2 += (v[j].x * v[j].x + v[j].y * v[j].y) + (v[j].z * v[j].z + v[j].w * v[j].w); }
        const float rstd = 1.0f / sqrtf(wave_sum(s2) * (1.0f / DM) + LN_EPS);
        GAS f32x4* xo = (GAS f32x4*)(xout + (size_t)row * DM) + F.lane;
        GAS unsigned long long* o8 = (GAS unsigned long long*)(F.U + (size_t)row * DM) + F.lane;
#pragma unroll
        for (int j = 0; j < 8; ++j) { const int col = 4 * F.lane + 256 * j;
            const f32x4 y = v[j] * rstd * *(const f32x4*)(g + col) + *(const f32x4*)(b + col);
            xo[64 * j] = y;
            if (WRITE_U) { const f32x4 u = y * (*(const f32x4*)(sc + col) + 1.0f) + *(const f32x4*)(sh + col);
                o8[64 * j] = (unsigned long long)pk2(u.x, u.y) | ((unsigned long long)pk2(u.z, u.w) << 32); } }
    }
}

__device__ __forceinline__ void p9_conv_naive(Frame& F) {
    const int gt = blockIdx.x * NTHREADS + F.tid, NT = F.G * NTHREADS;
    for (long idx = gt; idx < (long)SEQ * DFF; idx += NT) {
        const int t = (int)(idx / DFF), j = (int)(idx % DFF); const int pn = j >> 7, jj = j & 127, ca = 256 * pn + jj, cgc = ca + 128;
        float ya = F.conv_b[j], yg = F.conv_b[DFF + j];
#pragma unroll
        for (int i = 0; i < 3; ++i) { const int tt = t - 2 + i; if (tt >= 0) { ya += F.conv_w[i * NUP + j] * bf2f(F.H[(size_t)tt * NUP + ca]); yg += F.conv_w[i * NUP + DFF + j] * bf2f(F.H[(size_t)tt * NUP + cgc]); } }
        F.ACT[idx] = (bf16)f2bf(siluf(yg) * ya);
    }
}

__global__ void __launch_bounds__(NTHREADS, 2) mega(Args args) {
    extern __shared__ __attribute__((aligned(16))) unsigned char lds[];
    Frame F;
    F.lds = (LAS unsigned char*)lds; F.tid = threadIdx.x; F.lane = F.tid & 63; F.wave = __builtin_amdgcn_readfirstlane(F.tid >> 6); F.G = gridDim.x;
    F.x = args.in[0]; F.c = args.in[1]; F.pos = (const int*)args.in[2]; F.w_ada = args.in[3]; F.b_ada = args.in[4]; F.w_in = args.in[5]; F.w_gate = args.in[6]; F.b_gate = args.in[7];
    F.gnorm = args.in[8]; F.w_out = args.in[9]; F.ln1g = args.in[10]; F.ln1b = args.in[11]; F.w_up = args.in[12]; F.conv_w = args.in[13]; F.conv_b = args.in[14]; F.w_down = args.in[15];
    F.ln2g = args.in[16]; F.ln2b = args.in[17]; F.out = args.out; F.ws = args.ws;
    unsigned char* ws = args.ws;
    F.WinT = (bf16*)(ws + WS_WIN); F.WoutT = (bf16*)(ws + WS_WOUT); F.WupT = (bf16*)(ws + WS_WUP); F.WdownT = (bf16*)(ws + WS_WDOWN);
    F.U = (bf16*)(ws + WS_U) + U_PAD_ROWS * DM; F.PROJ = (bf16*)(ws + WS_PROJ); F.OCAT = (bf16*)(ws + WS_OCAT); F.H = (bf16*)(ws + WS_H); F.ACT = (bf16*)(ws + WS_ACT);
    F.MODP = (float*)(ws + WS_MISC + MISC_MODP); F.MOD = (float*)(ws + WS_MISC + MISC_MOD); F.GLR = (float*)(ws + WS_MISC + MISC_GLR);
    F.X1 = (float*)(ws + WS_X1); F.LOGA = (float*)(ws + WS_LOGA); F.OGRAW = (float*)(ws + WS_OGRAW);
    const int lo = args.ph_lo, hi = args.ph_hi;
#define IN(k) (lo <= (k) && (k) < hi)
#define SEAM(k) do { if (IN(k) && IN((k) + 1)) { cg::this_grid().sync(); } } while (0)
    if (IN(0)) { p0_prep(F); } SEAM(0);
    if (IN(1)) { p1_u(F); } SEAM(1);
    if (IN(2)) { pg8::Gemm g{F.U, F.WinT, SEQ, NPROJ, DM}; pg8::StaticOrder S; S.init(SEQ, NPROJ, F.G, (int)blockIdx.x);
        pg8::EpiBf16 E{F.PROJ, NPROJ, 0u, 1.f};
        pg8::gemm_phase<pg8::EpiBf16, pg8::StaticOrder, true, true>(F.lds, g, S, E); } SEAM(2);
    if (IN(3)) { p3_naive(F); } SEAM(3);
    if (IN(4)) { p4_naive(F); } SEAM(4);
    if (IN(5)) { p5_glapost(F); } SEAM(5);
    if (IN(6)) { pg8::Gemm g{F.OCAT, F.WoutT, SEQ, DM, DM}; pg8::StaticOrder S; S.init(SEQ, DM, F.G, (int)blockIdx.x);
        pg8::EpiResid E{F.x, F.out, DM, F.MOD + 2 * DM, ALPHA};
        pg8::gemm_phase<pg8::EpiResid, pg8::StaticOrder, true, true>(F.lds, g, S, E); } SEAM(6);
    if (IN(7)) { ln_rows<true>(F, F.out, F.X1, F.ln1g, F.ln1b, F.MOD + 3 * DM, F.MOD + 4 * DM); } SEAM(7);
    if (IN(8)) { pg8::Gemm g{F.U, F.WupT, SEQ, NUP, DM}; pg8::StaticOrder S; S.init(SEQ, NUP, F.G, (int)blockIdx.x);
        pg8::EpiBf16 E{F.H, NUP, 0u, 1.f};
        pg8::gemm_phase<pg8::EpiBf16, pg8::StaticOrder, true, true>(F.lds, g, S, E); } SEAM(8);
    if (IN(9)) { p9_conv_naive(F); } SEAM(9);
    if (IN(10)) { pg8::Gemm g{F.ACT, F.WdownT, SEQ, DM, DFF}; pg8::StaticOrder S; S.init(SEQ, DM, F.G, (int)blockIdx.x);
        pg8::EpiResid E{F.X1, F.out, DM, F.MOD + 5 * DM, ALPHA};
        pg8::gemm_phase<pg8::EpiResid, pg8::StaticOrder, true, true>(F.lds, g, S, E); } SEAM(10);
    if (IN(11)) { ln_rows<false>(F, F.out, F.out, F.ln2g, F.ln2b, nullptr, nullptr); }
#undef IN
#undef SEAM
}

constexpr int NPHASES = 12;
#ifndef MK_ONE_LAUNCH
#define MK_ONE_LAUNCH 0
#endif
extern "C" void kernel_launch(void* const* d_in, const int* in_sizes, int n_in, void* d_out, int out_size, void* d_ws, size_t ws_size, hipStream_t stream) {
    static int grid = 0;
    if (grid == 0) {
        if (n_in != 18 || out_size != SEQ * DM || ws_size < WS_END) { fprintf(stderr, "kernel_launch: unexpected shapes: n_in %d out %d ws %zu\n", n_in, out_size, ws_size); grid = -1; return; }
        int dev = 0, cus = 0, per_cu = 0;
        (void)hipGetDevice(&dev); (void)hipDeviceGetAttribute(&cus, hipDeviceAttributeMultiprocessorCount, dev);
        (void)hipFuncSetAttribute((const void*)mega, hipFuncAttributeMaxDynamicSharedMemorySize, LDS_BYTES);
        (void)hipOccupancyMaxActiveBlocksPerMultiprocessor(&per_cu, (const void*)mega, NTHREADS, LDS_BYTES);
        (void)hipGetLastError();
        if (per_cu < 1) { fprintf(stderr, "kernel_launch: occupancy query says %d blocks per CU\n", per_cu); per_cu = 1; }
        grid = cus;
    }
    if (grid < 0) return;
    Args a{};
    for (int i = 0; i < 18; ++i) a.in[i] = (const float*)d_in[i];
    a.out = (float*)d_out; a.ws = (unsigned char*)d_ws;
#if MK_ONE_LAUNCH
    a.ph_lo = 0; a.ph_hi = NPHASES;
    void* kargs[] = {&a};
    hipError_t e = hipLaunchCooperativeKernel((const void*)mega, dim3(grid), dim3(NTHREADS), kargs, LDS_BYTES, stream);
    if (e != hipSuccess) fprintf(stderr, "cooperative launch failed: %s (grid %d)\n", hipGetErrorString(e), grid);
#else
    for (int p = 0; p < NPHASES; ++p) { a.ph_lo = p; a.ph_hi = p + 1; hipLaunchKernelGGL(mega, dim3(grid), dim3(NTHREADS), LDS_BYTES, stream, a); }
#endif
}
```

```cpp
#include <hip/hip_runtime.h>
#include <hip/hip_cooperative_groups.h>
#include <cstdio>
#include <cstdint>
namespace cg = cooperative_groups;
namespace pg8 {
#define PG8_LAS __attribute__((address_space(3)))
typedef unsigned short bf16_t;
typedef short bf16x8 __attribute__((ext_vector_type(8)));
typedef float f32x4 __attribute__((ext_vector_type(4)));
typedef unsigned u32x4 __attribute__((ext_vector_type(4)));
constexpr int BM = 256, BK = 64, HALF = 128, HTB = HALF * BK * 2  , STAGE_BYTES = 8 * HTB, NXCD = 8, WGM = 8;

__host__ __device__ __forceinline__ int lds_byte(int r, int c) { const int st = (r >> 4) * 2 + (c >> 5), rr = r & 15, cc = c & 31, ob = rr * 64 + cc * 2; return st * 1024 + (ob ^ (((ob >> 9) & 1) << 5)); }
__host__ __device__ __forceinline__ void stage_rc(int b, int& R, int& C) { const int st = b / 1024, sb = b % 1024, swz = sb ^ (((sb >> 9) & 1) << 5); R = (st >> 1) * 16 + swz / 64; C = (st & 1) * 32 + (swz % 64) / 2; }
__host__ __device__ __forceinline__ int perm32(int rho) { const int n = rho >> 4, i = rho & 15; return 8 * (i >> 2) + 4 * n + (i & 3); }

struct Unit { int pm, pn; };
struct Gemm { const bf16_t* A; const bf16_t* Bt; int M, N, K; };

struct StaticOrder {
    int nM, nN, nwg, G, c;
    __host__ __device__ void init(int M, int N, int G_, int c_) { nM = M / BM; nN = N / BM; nwg = nM * nN; G = G_; c = c_; }
    __host__ __device__ bool next(int i, Unit& u) const {
        const long L = (long)i * G + c; if (L >= nwg) return false;
        int wgid = (int)L; { const int q = nwg / NXCD, r = nwg % NXCD, xcd = wgid % NXCD, off = wgid / NXCD; wgid = (xcd < r ? xcd * (q + 1) : r * (q + 1) + (xcd - r) * q) + off; }
        const int nig = WGM * nN, gid = wgid / nig, fm = gid * WGM, gsz = (nM - fm) < WGM ? (nM - fm) : WGM;
        u.pm = fm + ((wgid % nig) % gsz); u.pn = (wgid % nig) / gsz; return true;
    }
    __device__ __forceinline__ void a_ready(const Unit&) const {}
    __device__ __forceinline__ void done(const Unit&) const {}
};

__device__ __forceinline__ unsigned cvt_pk_bf16(float lo, float hi) { unsigned r; asm volatile("v_cvt_pk_bf16_f32 %0, %1, %2" : "=v"(r) : "v"(lo), "v"(hi)); return r; }
typedef float f32x2 __attribute__((ext_vector_type(2)));
struct EpiBf16 {
    static constexpr bool PERM = true, AFTER_DRAIN = false;
    bf16_t* O; int ldc; unsigned scale_mask; float scale;
    __device__ __forceinline__ void operator()(const f32x4 (&acc)[2][2][4][2], const Unit& u, int wr, int wc, int fr, int fq) const {
        const int row0 = u.pm * BM + wr * 64 + fr; const int colt = u.pn * BM;
        const float sc = ((scale_mask >> u.pn) & 1u) ? scale : 1.f;
        const int col0 = colt + wc * 32 + 8 * fq;
#pragma unroll
        for (int ai = 0; ai < 2; ++ai)
#pragma unroll
            for (int m = 0; m < 4; ++m) { bf16_t* rowp = O + (size_t)(row0 + ai * HALF + m * 16) * ldc + col0;
#pragma unroll
                for (int bj = 0; bj < 2; ++bj) { f32x4 v0 = acc[ai][bj][m][0] * sc, v1 = acc[ai][bj][m][1] * sc;
                    u32x4 w; w.x = cvt_pk_bf16(v0[0], v0[1]); w.y = cvt_pk_bf16(v0[2], v0[3]); w.z = cvt_pk_bf16(v1[0], v1[1]); w.w = cvt_pk_bf16(v1[2], v1[3]);
                    *(u32x4*)(rowp + bj * HALF) = w; } }
    }
};
struct EpiResid {
    static constexpr bool PERM = false, AFTER_DRAIN = false;
    const float* base; float* out; int ldc; const float* gate; float alpha;
    __device__ __forceinline__ void operator()(const f32x4 (&acc)[2][2][4][2], const Unit& u, int wr, int wc, int fr, int fq) const {
        const int col0 = u.pn * BM + wc * 32 + 4 * fq;
        f32x4 gv[2][2];
#pragma unroll
        for (int bj = 0; bj < 2; ++bj)
#pragma unroll
            for (int n = 0; n < 2; ++n) gv[bj][n] = *(const f32x4*)(gate + col0 + bj * HALF + n * 16) + 1.0f;
#pragma unroll
        for (int ai = 0; ai < 2; ++ai)
#pragma unroll
            for (int m = 0; m < 4; ++m) { const size_t off = (size_t)(u.pm * BM + ai * HALF + wr * 64 + m * 16 + fr) * ldc + col0;
#pragma unroll
                for (int bj = 0; bj < 2; ++bj)
#pragma unroll
                    for (int n = 0; n < 2; ++n) { const f32x4 bs = *(const f32x4*)(base + off + bj * HALF + n * 16);
                        *(f32x4*)(out + off + bj * HALF + n * 16) = bs * alpha + gv[bj][n] * acc[ai][bj][m][n]; } }
    }
};

struct EpiConv {
    static constexpr bool PERM = true, AFTER_DRAIN = false;
    bf16_t* ACT; const float* cw; const float* cb; int nff, ntok;
    __device__ __forceinline__ void operator()(const f32x4 (&acc)[2][2][4][2], const Unit& u, int wr, int wc, int fr, int fq) const {
        const int T0 = u.pm * 252 + wr * 126 - 2 + 8 * fr, jc = u.pn * 128 + wc * 32 + 8 * fq, n2 = 2 * nff;
#pragma unroll
        for (int n = 0; n < 2; ++n) { const int j0 = jc + 4 * n;
            const f32x4 w0a = *(const f32x4*)(cw + j0), w1a = *(const f32x4*)(cw + n2 + j0), w2a = *(const f32x4*)(cw + 2 * n2 + j0), ba = *(const f32x4*)(cb + j0);
            const f32x4 w0g = *(const f32x4*)(cw + nff + j0), w1g = *(const f32x4*)(cw + n2 + nff + j0), w2g = *(const f32x4*)(cw + 2 * n2 + nff + j0), bg = *(const f32x4*)(cb + nff + j0);
            f32x4 pa2, pa1, pg2, pg1;
#pragma unroll
            for (int e = 0; e < 4; ++e) { pa2[e] = __shfl_up(acc[1][0][2][n][e], 1, 16); pa1[e] = __shfl_up(acc[1][0][3][n][e], 1, 16); pg2[e] = __shfl_up(acc[1][1][2][n][e], 1, 16); pg1[e] = __shfl_up(acc[1][1][3][n][e], 1, 16); }
#pragma unroll
            for (int k = 0; k < 8; ++k) { const int ai = k >> 2, m = k & 3; const f32x4 ha = acc[ai][0][m][n], hg = acc[ai][1][m][n];
                const f32x4 ya = ba + w0a * pa2 + w1a * pa1 + w2a * ha, yg = bg + w0g * pg2 + w1g * pg1 + w2g * hg;
                pa2 = pa1; pa1 = ha; pg2 = pg1; pg1 = hg;
                const int T = T0 + k;
                if ((fr != 0 || k >= 2) && T < ntok) { f32x4 a;
#pragma unroll
                    for (int e = 0; e < 4; ++e) a[e] = ya[e] * yg[e] * __builtin_amdgcn_rcpf(1.0f + __expf(-yg[e]));
                    *(unsigned long long*)(ACT + (size_t)T * nff + j0) = (unsigned long long)cvt_pk_bf16(a[0], a[1]) | ((unsigned long long)cvt_pk_bf16(a[2], a[3]) << 32); } } }
    }
};
template <class Epi, class Sched, bool ALIGN_EPI = false, bool SP2 = false, bool AMAP = false>
__device__ __forceinline__ void gemm_phase(PG8_LAS unsigned char* lds, const Gemm g, const Sched& S, const Epi& E) {
    const int tid = threadIdx.x, wid = __builtin_amdgcn_readfirstlane(tid >> 6), lane = tid & 63, wr = wid >> 2, wc = wid & 3, fr = lane & 15, fq = lane >> 4;
    const int K = g.K, nt = K / BK;
    unsigned voffA[2], voffB[2];
#pragma unroll
    for (int i = 0; i < 2; ++i) { int R, C; stage_rc(tid * 16 + i * 8192, R, C); const int Rb = Epi::PERM ? ((R & ~31) + perm32(R & 31)) : R;
        voffA[i] = AMAP ? (unsigned)((126 * (R >> 6) + 8 * (R & 15) + ((R >> 4) & 3)) * K + C) * 2u : (unsigned)(R * K + C) * 2u; voffB[i] = (unsigned)(Rb * K + C) * 2u; }
    const size_t kstep = (size_t)(BK * 2);
    const size_t hstep = (size_t)HALF * K * 2;
    const size_t tstep = 2 * hstep;
    const size_t hstepA = AMAP ? (size_t)4 * K * 2 : hstep, tstepA = AMAP ? (size_t)252 * K * 2 : tstep;
    const unsigned ldsw = (unsigned)wid * 1024u;
    const int aoff = lds_byte(wr * 64 + fr, fq * 8), boff = lds_byte(wc * 32 + fr, fq * 8);
#define PG8_SA(b, h) (((b) * 2 + (h)) * HTB)
#define PG8_SB(b, h) ((4 + (b) * 2 + (h)) * HTB)
#define PG8_STAGE(bufoff, gbase, voff) do { _Pragma("unroll") for (int _i = 0; _i < 2; ++_i) \
        __builtin_amdgcn_global_load_lds((const unsigned*)((const char*)(gbase) + (voff)[_i]), (PG8_LAS unsigned*)(lds + (bufoff) + ldsw + _i * 8192), 16, 0, 0); } while (0)
#define PG8_LDA(dst, b, h) do { _Pragma("unroll") for (int m = 0; m < 4; ++m) _Pragma("unroll") for (int k = 0; k < 2; ++k) dst[m][k] = *(const PG8_LAS bf16x8*)(lds + PG8_SA(b, h) + aoff + m * 2048 + k * 1024); } while (0)
#define PG8_LDB(dst, b, h) do { _Pragma("unroll") for (int n = 0; n < 2; ++n) _Pragma("unroll") for (int k = 0; k < 2; ++k) dst[n][k] = *(const PG8_LAS bf16x8*)(lds + PG8_SB(b, h) + boff + n * 2048 + k * 1024); } while (0)
#define PG8_MMA(ai, bj, At, Bt) do { __builtin_amdgcn_s_setprio(1); _Pragma("unroll") for (int m = 0; m < 4; ++m) _Pragma("unroll") for (int n = 0; n < 2; ++n) _Pragma("unroll") for (int k = 0; k < 2; ++k) \
        acc[ai][bj][m][n] = __builtin_amdgcn_mfma_f32_16x16x32_bf16(Bt[n][k], At[m][k], acc[ai][bj][m][n], 0, 0, 0); __builtin_amdgcn_s_setprio(0); } while (0)
#define PG8_WAIT_V(n) asm volatile("s_waitcnt vmcnt(" #n ")" ::: "memory")
#define PG8_WAIT_L(n) asm volatile("s_waitcnt lgkmcnt(" #n ")" ::: "memory")
#define PG8_BAR __builtin_amdgcn_s_barrier()
#define PG8_SCHED __builtin_amdgcn_sched_barrier(0)
    Unit cur, nxt; int ui = 0;
    if (!S.next(0, cur)) return;
    f32x4 acc[2][2][4][2];
#pragma unroll
    for (int a = 0; a < 2; ++a)
#pragma unroll
        for (int b = 0; b < 2; ++b)
#pragma unroll
            for (int m = 0; m < 4; ++m)
#pragma unroll
                for (int n = 0; n < 2; ++n) acc[a][b][m][n] = (f32x4){0.f, 0.f, 0.f, 0.f};
    bf16x8 At[4][2], B0[2][2], B1[2][2];
    const char* cA = (const char*)g.A + (size_t)cur.pm * tstepA; const char* cB = (const char*)g.Bt + (size_t)cur.pn * tstep;
    S.a_ready(cur);
    if constexpr (SP2) {
        PG8_STAGE(PG8_SB(0, 0), cB, voffB); PG8_STAGE(PG8_SB(0, 1), cB + hstep, voffB); PG8_STAGE(PG8_SA(0, 0), cA, voffA); PG8_STAGE(PG8_SA(0, 1), cA + hstepA, voffA);
        if (wr == 1) PG8_BAR;
        PG8_WAIT_V(2); PG8_BAR;
        PG8_STAGE(PG8_SB(1, 0), cB + kstep, voffB); PG8_STAGE(PG8_SA(1, 0), cA + kstep, voffA); PG8_STAGE(PG8_SB(1, 1), cB + hstep + kstep, voffB);
        PG8_WAIT_V(6); PG8_BAR;
    } else {
        PG8_STAGE(PG8_SB(0, 0), cB, voffB); PG8_STAGE(PG8_SA(0, 0), cA, voffA); PG8_STAGE(PG8_SB(0, 1), cB + hstep, voffB); PG8_STAGE(PG8_SA(0, 1), cA + hstepA, voffA);
        if (wr == 1) PG8_BAR;
        PG8_WAIT_V(4); PG8_BAR;
        PG8_STAGE(PG8_SB(1, 0), cB + kstep, voffB); PG8_STAGE(PG8_SA(1, 0), cA + kstep, voffA); PG8_STAGE(PG8_SB(1, 1), cB + hstep + kstep, voffB);
        PG8_WAIT_V(6); PG8_BAR;
    }
    for (;;) {
        const bool has_next = S.next(ui + 1, nxt);
        const char* nA = has_next ? (const char*)g.A + (size_t)nxt.pm * tstepA : cA; const char* nB = has_next ? (const char*)g.Bt + (size_t)nxt.pn * tstep : cB;
        for (int t = 0; t < nt; t += 2) {
            const bool last = (t == nt - 2);
            const char* a1 = cA + (size_t)(t + 1) * kstep;
            const char* a2 = last ? nA : cA + (size_t)(t + 2) * kstep; const char* b2 = last ? nB : cB + (size_t)(t + 2) * kstep;
            const char* a3 = a2 + kstep; const char* b3 = b2 + kstep;
            if (last && has_next) S.a_ready(nxt);
            if constexpr (SP2) {
            PG8_LDB(B0, 0, 0); PG8_LDB(B1, 0, 1); PG8_SCHED; PG8_LDA(At, 0, 0); PG8_STAGE(PG8_SA(1, 1), a1 + hstepA, voffA);
            PG8_WAIT_V(8); PG8_WAIT_L(0); PG8_BAR; PG8_MMA(0, 0, At, B0); PG8_MMA(0, 1, At, B1); PG8_BAR; PG8_SCHED;
            PG8_LDA(At, 0, 1); PG8_STAGE(PG8_SB(0, 0), b2, voffB); PG8_STAGE(PG8_SB(0, 1), b2 + hstep, voffB); PG8_STAGE(PG8_SA(0, 0), a2, voffA);
            PG8_WAIT_V(8); PG8_WAIT_L(0); PG8_BAR; PG8_MMA(1, 0, At, B0); PG8_MMA(1, 1, At, B1); PG8_BAR; PG8_SCHED;
            PG8_LDB(B0, 1, 0); PG8_LDB(B1, 1, 1); PG8_SCHED; PG8_LDA(At, 1, 0); PG8_STAGE(PG8_SA(0, 1), a2 + hstepA, voffA);
            PG8_WAIT_V(8); PG8_WAIT_L(0); PG8_BAR; PG8_MMA(0, 0, At, B0); PG8_MMA(0, 1, At, B1); PG8_BAR; PG8_SCHED;
            PG8_LDA(At, 1, 1); PG8_STAGE(PG8_SB(1, 0), b3, voffB); PG8_STAGE(PG8_SB(1, 1), b3 + hstep, voffB); PG8_STAGE(PG8_SA(1, 0), a3, voffA);
            PG8_WAIT_V(8); PG8_WAIT_L(0); PG8_BAR; PG8_MMA(1, 0, At, B0); PG8_MMA(1, 1, At, B1); PG8_BAR; PG8_SCHED;
            } else {
            PG8_LDB(B0, 0, 0); PG8_SCHED; PG8_LDA(At, 0, 0); PG8_STAGE(PG8_SA(1, 1), a1 + hstepA, voffA);
            PG8_WAIT_L(8); PG8_BAR; PG8_WAIT_L(0); PG8_MMA(0, 0, At, B0); PG8_BAR; PG8_SCHED;
            PG8_LDB(B1, 0, 1); PG8_STAGE(PG8_SB(0, 0), b2, voffB);
            PG8_BAR; PG8_WAIT_L(0); PG8_MMA(0, 1, At, B1); PG8_BAR;
            PG8_LDA(At, 0, 1); PG8_STAGE(PG8_SA(0, 0), a2, voffA);
            PG8_BAR; PG8_WAIT_L(0); PG8_MMA(1, 0, At, B0); PG8_BAR; PG8_SCHED;
            PG8_STAGE(PG8_SB(0, 1), b2 + hstep, voffB);
            PG8_WAIT_V(6); PG8_BAR; PG8_MMA(1, 1, At, B1); PG8_BAR;
            PG8_LDB(B0, 1, 0); PG8_SCHED; PG8_LDA(At, 1, 0); PG8_STAGE(PG8_SA(0, 1), a2 + hstepA, voffA);
            PG8_WAIT_L(8); PG8_BAR; PG8_WAIT_L(0); PG8_MMA(0, 0, At, B0); PG8_BAR; PG8_SCHED;
            PG8_LDB(B1, 1, 1); PG8_STAGE(PG8_SB(1, 0), b3, voffB);
            PG8_BAR; PG8_WAIT_L(0); PG8_MMA(0, 1, At, B1); PG8_BAR;
            PG8_LDA(At, 1, 1); PG8_STAGE(PG8_SA(1, 0), a3, voffA);
            PG8_BAR; PG8_WAIT_L(0); PG8_MMA(1, 0, At, B0); PG8_BAR; PG8_SCHED;
            PG8_STAGE(PG8_SB(1, 1), b3 + hstep, voffB);
            PG8_WAIT_V(6); PG8_BAR; PG8_MMA(1, 1, At, B1); PG8_BAR;
            }
        }
        if constexpr (ALIGN_EPI) { if (wr == 0) PG8_BAR; }
        if constexpr (!Epi::AFTER_DRAIN) { E(acc, cur, wr, wc, fr, fq); S.done(cur); }
        if (!has_next) break;
#pragma unroll
        for (int a = 0; a < 2; ++a)
#pragma unroll
            for (int b = 0; b < 2; ++b)
#pragma unroll
                for (int m = 0; m < 4; ++m)
#pragma unroll
                    for (int n = 0; n < 2; ++n) acc[a][b][m][n] = (f32x4){0.f, 0.f, 0.f, 0.f};
        cur = nxt; cA = nA; cB = nB; ++ui;
        if constexpr (ALIGN_EPI) { if (wr == 1) PG8_BAR; }
    }
    PG8_WAIT_V(0);
    if constexpr (!ALIGN_EPI) { if (wr == 0) PG8_BAR; }
    PG8_BAR;
    if constexpr (Epi::AFTER_DRAIN) { E.fused(acc, cur, wr, wc, fr, fq, lds, wid, lane); S.done(cur); }
#undef PG8_SA
#undef PG8_SB
#undef PG8_STAGE
#undef PG8_LDA
#undef PG8_LDB
#undef PG8_MMA
#undef PG8_WAIT_V
#undef PG8_WAIT_L
#undef PG8_BAR
#undef PG8_SCHED
}
}
#define GAS __attribute__((address_space(1)))
#define LAS __attribute__((address_space(3)))
typedef unsigned short bf16;
typedef unsigned v4u __attribute__((ext_vector_type(4)));
typedef float f32x4 __attribute__((ext_vector_type(4)));
typedef short bf16x8 __attribute__((ext_vector_type(8)));
typedef GAS unsigned gu32;
typedef GAS unsigned long long gu64;
#define RLX_AGENT __ATOMIC_RELAXED, __HIP_MEMORY_SCOPE_AGENT
#define LDS_WAIT() asm volatile("s_waitcnt lgkmcnt(0)" ::: "memory")
#define VM_WAIT() asm volatile("s_waitcnt vmcnt(0)" ::: "memory")
__device__ __forceinline__ unsigned long long rt() { return __builtin_amdgcn_s_memrealtime(); }
__device__ __forceinline__ unsigned f2bf(float f) { unsigned u = __builtin_bit_cast(unsigned, f); return (u + 0x7fffu + ((u >> 16) & 1u)) >> 16; }
__device__ __forceinline__ unsigned pk2(float lo, float hi) { return f2bf(lo) | (f2bf(hi) << 16); }

#define XB_TMO      128
#define XB_XCNT(j)  (256  + 64 * (j))
#define XB_XSUB(j)  (1280 + 64 * (j))
#define XB_XGEN(j)  (2304 + 64 * (j))
#define XB_TOP      3328
#define XB_TOPGEN   3392
#define XCD_BAR_WORDS 3456
#define XB_SPIN_CAP (1u << 18)

__device__ __forceinline__ unsigned xb_ld(unsigned* p)              { return __hip_atomic_load(p, __ATOMIC_RELAXED, __HIP_MEMORY_SCOPE_AGENT); }
__device__ __forceinline__ unsigned xb_add(unsigned* p, unsigned v) { return __hip_atomic_fetch_add(p, v, __ATOMIC_RELAXED, __HIP_MEMORY_SCOPE_AGENT); }
__device__ __forceinline__ unsigned xb_xcc_id() { return (unsigned)__builtin_amdgcn_s_getreg((3 << 11) | 20) & 0xFu; }
#define XB_SPIN(cond, bar) do { unsigned _sp = 0; while (cond) { __builtin_amdgcn_s_sleep(1); \
    if ((++_sp & 255u) == 0u) { if (xb_ld(&(bar)[XB_TMO])) break; if (_sp > XB_SPIN_CAP) { atomicAdd(&(bar)[XB_TMO], 1u); break; } } } } while (0)

struct XcdBarrier {
    unsigned* bar; unsigned x;
    volatile LAS unsigned* st;
};

__device__ __forceinline__ XcdBarrier xcd_barrier_post(unsigned* bar, volatile LAS unsigned* st) {
    XcdBarrier b; b.bar = bar; b.x = xb_xcc_id(); b.st = st;
    if (threadIdx.x == 0) (void)xb_add(&bar[XB_XCNT(b.x)], 1u);
    return b;
}
__device__ __forceinline__ void xcd_barrier_complete(unsigned* bar, unsigned x, unsigned& nloc, unsigned& nx) {
    const unsigned G = gridDim.x * gridDim.y * gridDim.z;
    unsigned sum, cnt, mine, sp = 0u;
    for (;;) {
        sum = 0u; cnt = 0u; mine = 0u;
#pragma unroll
        for (unsigned j = 0; j < 16; ++j) { const unsigned c = xb_ld(&bar[XB_XCNT(j)]); sum += c; cnt += (c > 0u) ? 1u : 0u; mine = (j == x) ? c : mine; }
        if (sum == G) break;
        __builtin_amdgcn_s_sleep(1);
        if ((++sp & 255u) == 0u) { if (xb_ld(&bar[XB_TMO])) break; if (sp > XB_SPIN_CAP) { atomicAdd(&bar[XB_TMO], 1u); break; } }
    }
    nloc = mine > 0u ? mine : 1u; nx = cnt > 0u ? cnt : 1u;
}

__device__ __forceinline__ void xcd_barrier(const XcdBarrier& b) {
    asm volatile("s_waitcnt vmcnt(0)" ::: "memory");
    __syncthreads();
    if (threadIdx.x == 0) {
        unsigned* bar = b.bar;
        __builtin_amdgcn_s_waitcnt(0);
        unsigned nloc = b.st[0], nx = b.st[1];
        if (nloc == 0u) { xcd_barrier_complete(bar, b.x, nloc, nx); b.st[0] = nloc; b.st[1] = nx; }
        const unsigned old = xb_add(&bar[XB_XSUB(b.x)], 1u);
        const unsigned gen = old / nloc;
        if (old + 1u == (gen + 1u) * nloc) {
            __builtin_amdgcn_fence(__ATOMIC_RELEASE, "agent");
            asm volatile("s_waitcnt vmcnt(0)" ::: "memory");
            const unsigned og = xb_add(&bar[XB_TOP], 1u);
            const unsigned tg = og / nx;
            if (og + 1u == (tg + 1u) * nx) xb_add(&bar[XB_TOPGEN], 1u);
            else XB_SPIN(xb_ld(&bar[XB_TOPGEN]) == tg, bar);
            __builtin_amdgcn_fence(__ATOMIC_ACQUIRE, "agent");
            xb_add(&bar[XB_XGEN(b.x)], 1u);
            asm volatile("s_waitcnt vmcnt(0)" ::: "memory");
        } else {
            XB_SPIN(xb_ld(&bar[XB_XGEN(b.x)]) == gen, bar);
            __builtin_amdgcn_fence(__ATOMIC_ACQUIRE, "agent");
            asm volatile("s_waitcnt vmcnt(0)" ::: "memory");
        }
    }
    __syncthreads();
}
constexpr int NWAVES = 8, NTHREADS = 512;
constexpr int DM = 2048, SEQ = 8192, DFF = 5632, NUP = 2 * DFF;
constexpr int NPROJ = 6144;
constexpr int C_GQ = 0, C_GK = 512, C_GV = 1024, C_GR = 2048, C_AQ = 3072, C_AK = 4096, C_AV = 5120;
constexpr int WIN_LD = 6160, LR_COL = 3072;
constexpr float ALPHA = 1.189207115002721f;
constexpr float LN_EPS = 1e-5f, RMS_EPS = 1e-6f;
constexpr float QSCALE = 0.08838834764831845f;

constexpr size_t MiB = 1u << 20;
constexpr size_t WS_CTL = 0, CTL_ZERO_BYTES = 1 * MiB;
constexpr size_t WS_WDOWN = 1 * MiB, WS_WIN = 23 * MiB, WS_WOUT = 47 * MiB, WS_WUP = 55 * MiB;
constexpr size_t WS_U = 99 * MiB, U_PAD_ROWS = 2, U_ROWS_ALLOC = 8320;
constexpr size_t WS_MISC = 132 * MiB;
constexpr size_t MISC_MODP = 0, MISC_MOD = 512 * 1024, MISC_GLR = 1 * MiB, MISC_WLR = 2 * MiB, MISC_DEC = 3 * MiB;
constexpr size_t WS_KVT = 136 * MiB;
constexpr size_t WS_ST = 312 * MiB;
constexpr size_t WS_X1 = 136 * MiB;
constexpr size_t WS_PROJ = 200 * MiB, WS_LOGA = 296 * MiB, WS_OGRAW = 312 * MiB, WS_OCAT = 344 * MiB;
constexpr size_t WS_H = 200 * MiB;
constexpr size_t WS_ACT = 200 * MiB;
constexpr size_t WS_END = 384 * MiB;
constexpr int CW_BAR = 4096;

constexpr int LDS_BYTES = 147456;
constexpr int RING_BYTES = 131072, MISC_OFF = RING_BYTES + 320;

struct Args { const float* in[18]; float* out; unsigned char* ws; int ph_lo, ph_hi; };

struct Frame {
    LAS unsigned char* lds; int tid, lane, wave, G;
    const float *x, *c, *w_ada, *b_ada, *w_in, *w_gate, *b_gate, *gnorm, *w_out, *ln1g, *ln1b, *w_up, *conv_w, *conv_b, *w_down, *ln2g, *ln2b;
    const int* pos;
    float* out; unsigned char* ws;
    bf16 *WinT, *WoutT, *WupT, *WdownT, *U, *PROJ, *OCAT, *H, *ACT, *WlrT;
    float *MODP, *MOD, *GLR, *X1, *LOGA, *OGRAW, *KVT, *DEC; bf16* ST;
};

__device__ __forceinline__ float bf2f(bf16 v) { return __builtin_bit_cast(float, (unsigned)v << 16); }
__device__ __forceinline__ float wave_sum(float v) {
#pragma unroll
    for (int o = 1; o < 64; o <<= 1) v += __shfl_xor(v, o);
    return v;
}
__device__ __forceinline__ float siluf(float v) { return v / (1.0f + __expf(-v)); }

__device__ __forceinline__ void transpose_item(const float* W, int ldn, int K, int k0, int srcn0, bf16* WT, int dstn0, LAS float* scr, int lane) {
#pragma unroll 8
    for (int i = 0; i < 32; ++i) { const int kk = 2 * i + (lane >> 5); scr[kk * 33 + (lane & 31)] = W[(size_t)(k0 + kk) * ldn + srcn0 + (lane & 31)]; }
    LDS_WAIT(); asm volatile("" ::: "memory");
    const int c = lane & 7;
#pragma unroll
    for (int j = 0; j < 4; ++j) { const int n = (lane >> 3) + 8 * j; const LAS float* s = scr + (8 * c) * 33 + n;
        v4u o; o.x = pk2(s[0 * 33], s[1 * 33]); o.y = pk2(s[2 * 33], s[3 * 33]); o.z = pk2(s[4 * 33], s[5 * 33]); o.w = pk2(s[6 * 33], s[7 * 33]);
        *(GAS v4u*)(WT + (size_t)(dstn0 + n) * K + k0 + 8 * c) = o; }
    LDS_WAIT(); asm volatile("" ::: "memory");
}
__device__ __forceinline__ void p0_prep(Frame& F) {
    LAS float* red = (LAS float*)F.lds;
    for (int it = blockIdx.x; it < 384; it += F.G) {
        const int cgp = it % 48, kg = it / 48;
        f32x4 acc = {0.f, 0.f, 0.f, 0.f};
        const float* wp = F.w_ada + (size_t)(kg * 256 + F.wave * 32) * 12288 + cgp * 256 + 4 * F.lane;
#pragma unroll 8
        for (int kk = 0; kk < 32; ++kk) { const float s = siluf(F.c[kg * 256 + F.wave * 32 + kk]); acc += *(const f32x4*)(wp + (size_t)kk * 12288) * s; }
        __syncthreads();
        *(LAS f32x4*)(red + F.wave * 256 + 4 * F.lane) = acc;
        __syncthreads();
        if (F.tid < 256) { float s = 0.f;
#pragma unroll
            for (int w = 0; w < 8; ++w) s += red[w * 256 + F.tid];
            F.MODP[kg * 12288 + cgp * 256 + F.tid] = s; }
    }
    __syncthreads();
    LAS float* scr = (LAS float*)(F.lds + F.wave * 16384);
    const int gw = blockIdx.x * NWAVES + F.wave, NGW = F.G * NWAVES;
    constexpr int I_IN = 32 * 192, I_OUT = 32 * 64, I_UP = 32 * 352, I_DN = 88 * 64, NITEMS = I_IN + I_OUT + I_UP + I_DN;
    for (int it = gw; it < NITEMS; it += NGW) {
        int r = it;
        if (r < I_IN) { const int kb = r / 192, db = r % 192; transpose_item(F.w_in, WIN_LD, DM, kb * 64, db * 32 + (db >= 96 ? 16 : 0), F.WinT, db * 32, scr, F.lane); continue; } r -= I_IN;
        if (r < I_OUT) { const int kb = r / 64, db = r % 64; transpose_item(F.w_out, DM, DM, kb * 64, db * 32, F.WoutT, db * 32, scr, F.lane); continue; } r -= I_OUT;
        if (r < I_UP) { const int kb = r / 352, db = r % 352; const int pn = db >> 3, half = (db >> 2) & 1, q = db & 3;
            transpose_item(F.w_up, NUP, DM, kb * 64, half * DFF + pn * 128 + q * 32, F.WupT, db * 32, scr, F.lane); continue; } r -= I_UP;
        { const int kb = r / 64, db = r % 64; transpose_item(F.w_down, DM, DFF, kb * 64, db * 32, F.WdownT, db * 32, scr, F.lane); }
    }
    { const int gt = blockIdx.x * NTHREADS + F.tid, NT = F.G * NTHREADS;
      for (int i = gt; i < 16 * DM; i += NT) { const int j = i >> 11, k = i & 2047; F.WlrT[i] = (bf16)f2bf(F.w_in[(size_t)k * WIN_LD + LR_COL + j]); } }
    { bf16* ub = F.U - U_PAD_ROWS * DM; const int gt = blockIdx.x * NTHREADS + F.tid, NT = F.G * NTHREADS;
      for (int i = gt; i < (int)U_PAD_ROWS * DM / 8; i += NT) ((GAS v4u*)ub)[i] = (v4u){0u, 0u, 0u, 0u};
      GAS v4u* tail = (GAS v4u*)(F.U + (size_t)SEQ * DM);
      for (int i = gt; i < (int)(U_ROWS_ALLOC - U_PAD_ROWS - SEQ) * DM / 8; i += NT) tail[i] = (v4u){0u, 0u, 0u, 0u}; }
}

__device__ __forceinline__ void p1_u(Frame& F) {
    LAS float* smod = (LAS float*)F.lds;
    for (int i = F.tid; i < 12288; i += NTHREADS) {
        float s = F.b_ada[i];
#pragma unroll
        for (int p = 0; p < 8; ++p) s += F.MODP[p * 12288 + i];
        if (i < 4096) smod[i] = s;
        if (blockIdx.x == 0) F.MOD[i] = s;
    }
    __syncthreads();
    const int gw = blockIdx.x * NWAVES + F.wave, NGW = F.G * NWAVES;
    for (int row = gw; row < SEQ; row += NGW) {
        const GAS f32x4* xr = (const GAS f32x4*)(F.x + (size_t)row * DM) + F.lane;
        GAS unsigned long long* o8 = (GAS unsigned long long*)(F.U + (size_t)row * DM) + F.lane;
#pragma unroll
        for (int j = 0; j < 8; ++j) {
            const f32x4 xv = xr[64 * j]; const int col = 4 * F.lane + 256 * j;
            const f32x4 sh = *(LAS f32x4*)(smod + col), sc = *(LAS f32x4*)(smod + 2048 + col);
            const f32x4 u = xv * (sc + 1.0f) + sh;
            o8[64 * j] = (unsigned long long)pk2(u.x, u.y) | ((unsigned long long)pk2(u.z, u.w) << 32);
        }
    }
}

__device__ __forceinline__ void glr_gemm(Frame& F) {
    const int l = F.lane, i16 = l & 15, g = l >> 4, rg = F.wave & 1, kq = F.wave >> 1;
    LAS f32x4* red = (LAS f32x4*)F.lds;
    for (int rb = blockIdx.x; rb < SEQ / 32; rb += F.G) {
        const bf16* ap = F.U + (size_t)(32 * rb + 16 * rg + i16) * DM + kq * 512 + 8 * g; const bf16* bp = F.WlrT + (size_t)i16 * DM + kq * 512 + 8 * g;
        f32x4 acc = {0.f, 0.f, 0.f, 0.f};
#pragma unroll 4
        for (int ks = 0; ks < 16; ++ks) acc = __builtin_amdgcn_mfma_f32_16x16x32_bf16(*(const bf16x8*)(ap + 32 * ks), *(const bf16x8*)(bp + 32 * ks), acc, 0, 0, 0);
        __syncthreads();
        red[F.wave * 64 + l] = acc;
        __syncthreads();
        if (kq == 0) { const f32x4 s = (red[rg * 64 + l] + red[(2 + rg) * 64 + l]) + (red[(4 + rg) * 64 + l] + red[(6 + rg) * 64 + l]);
#pragma unroll
            for (int i = 0; i < 4; ++i) F.GLR[(size_t)(32 * rb + 16 * rg + 4 * g + i) * 16 + i16] = s[i]; }
    }
    __syncthreads();
}

__device__ __forceinline__ void p3_naive(Frame& F) {
    const int gt = blockIdx.x * NTHREADS + F.tid, NT = F.G * NTHREADS;
    for (int idx = gt; idx < SEQ * 2 * 8 * 64; idx += NT) {
        const int i = idx & 63, h = (idx >> 6) & 7, which = (idx >> 9) & 1, t = idx >> 10;
        bf16* p = F.PROJ + (size_t)t * NPROJ + (which ? C_AK : C_AQ) + h * 128 + i;
        const float a = bf2f(p[0]), b = bf2f(p[64]);
        const float inv_freq = powf(10000.0f, -(float)i / 64.0f);
        const float ang = (float)F.pos[t] * inv_freq; float sn, cs; sincosf(ang, &sn, &cs);
        const float sc = 1.0f;
        p[0] = (bf16)f2bf((a * cs - b * sn) * sc); p[64] = (bf16)f2bf((b * cs + a * sn) * sc);
    }
}

__device__ __forceinline__ void p4_naive(Frame& F) {
    {
        LAS float* sc = (LAS float*)(F.lds + F.wave * 2048);
        const int gw = blockIdx.x * NWAVES + F.wave, NGW = F.G * NWAVES, l = F.lane;
        for (int item = gw; item < SEQ * 8; item += NGW) {
            const int t = item >> 3, h = item & 7;
            const unsigned qq = *(const unsigned*)(F.PROJ + (size_t)t * NPROJ + C_AQ + h * 128 + 2 * l);
            const float q0 = __builtin_bit_cast(float, qq << 16), q1 = __builtin_bit_cast(float, qq & 0xffff0000u);
            float m = -INFINITY;
            for (int b = 0; b < 3; ++b) { const int r = b == 0 ? 1 : (b == 1 ? 4 : 16); const int jmax = min(128, t / r);
                for (int j = 0; j <= jmax; ++j) { const int s = t - j * r;
                    const unsigned kk = *(const unsigned*)(F.PROJ + (size_t)s * NPROJ + C_AK + h * 128 + 2 * l);
                    float p = q0 * __builtin_bit_cast(float, kk << 16) + q1 * __builtin_bit_cast(float, kk & 0xffff0000u);
                    p = wave_sum(p); m = fmaxf(m, p); if (l == 0) sc[b * 129 + j] = p; }
                if (l == 0) for (int j = jmax + 1; j <= 128; ++j) sc[b * 129 + j] = -INFINITY; }
            LDS_WAIT(); asm volatile("" ::: "memory");
            float lsum = 0.f, o0 = 0.f, o1 = 0.f;
            for (int b = 0; b < 3; ++b) { const int r = b == 0 ? 1 : (b == 1 ? 4 : 16); const int jmax = min(128, t / r);
                for (int j = 0; j <= jmax; ++j) { const int s = t - j * r; const float w = expf(sc[b * 129 + j] - m); lsum += w;
                    const unsigned vv = *(const unsigned*)(F.PROJ + (size_t)s * NPROJ + C_AV + h * 128 + 2 * l);
                    o0 += w * __builtin_bit_cast(float, vv << 16); o1 += w * __builtin_bit_cast(float, vv & 0xffff0000u); } }
            const float inv = 1.0f / lsum;
            *(unsigned*)(F.OCAT + (size_t)t * DM + 1024 + h * 128 + 2 * l) = pk2(o0 * inv, o1 * inv);
            LDS_WAIT(); asm volatile("" ::: "memory");
        }
    }
}


typedef short s16x4 __attribute__((ext_vector_type(4)));
#define TR16(p) __builtin_amdgcn_ds_read_tr16_b64_v4i16((LAS s16x4*)(p))
__device__ __forceinline__ bf16x8 cat8(s16x4 a, s16x4 b) { return (bf16x8){a[0], a[1], a[2], a[3], b[0], b[1], b[2], b[3]}; }
constexpr int GLA_GLRS = 0, GLA_BPART = 4096, GLA_QT = 8192, GLA_KT = 26624, GLA_VT = 45056, GLA_RMS = 79872;
template <int MODE> __device__ __forceinline__ void gla_stage(Frame& F, int h, int c) {
    LAS float* glrs = (LAS float*)(F.lds + GLA_GLRS); LAS float* bpart = (LAS float*)(F.lds + GLA_BPART);
    LAS bf16* QT = (LAS bf16*)(F.lds + GLA_QT); LAS bf16* KT = (LAS bf16*)(F.lds + GLA_KT);
    const int t0 = c * 64, d = F.tid & 127, qt = F.tid >> 7;
    __syncthreads();
    if (F.tid < 256) *(LAS f32x4*)(glrs + 4 * F.tid) = *(const f32x4*)(F.GLR + (size_t)t0 * 16 + 4 * F.tid);
#pragma unroll
    for (int i = 0; i < 4; ++i) { const int id = F.tid + 512 * i, row = id >> 5, chn = id & 31;
        *(LAS v4u*)(F.lds + GLA_VT + row * 544 + chn * 16) = *(const v4u*)(F.PROJ + (size_t)(t0 + row) * NPROJ + C_GV + h * 256 + chn * 8); }
    float wg[16];
#pragma unroll
    for (int j = 0; j < 16; ++j) wg[j] = F.w_gate[j * 512 + h * 128 + d];
    const float bgv = F.b_gate[h * 128 + d];
    __syncthreads();
    float bl[16]; float run = 0.f;
#pragma unroll
    for (int tt = 0; tt < 16; ++tt) { const int t = 16 * qt + tt; float z = bgv;
#pragma unroll
        for (int j = 0; j < 16; ++j) z += glrs[t * 16 + j] * wg[j];
        run += (fminf(z, 0.f) - log1pf(expf(-fabsf(z)))) * (1.0f / 16.0f); bl[tt] = run; }
    bpart[qt * 128 + d] = run;
    __syncthreads();
    float off = 0.f, blast = 0.f;
#pragma unroll
    for (int q2 = 0; q2 < 4; ++q2) { const float v = bpart[q2 * 128 + d]; blast += v; if (q2 < qt) off += v; }
#pragma unroll
    for (int tt = 0; tt < 16; ++tt) { const int t = 16 * qt + tt; const float b = off + bl[tt]; const size_t row = (size_t)(t0 + t) * NPROJ;
        const float kf = bf2f(F.PROJ[row + C_GK + h * 128 + d]);
        if (MODE == 0) { KT[t * 144 + d] = (bf16)f2bf(kf * expf(blast - b)); }
        else { const float qf = bf2f(F.PROJ[row + C_GQ + h * 128 + d]); QT[t * 144 + d] = (bf16)f2bf(qf * expf(b)); KT[t * 144 + d] = (bf16)f2bf(kf * expf(-b)); } }
    if (MODE == 0 && qt == 0) F.DEC[(h * 128 + c) * 128 + d] = expf(blast);
    __syncthreads();
}
__device__ __forceinline__ void gla_pass_a_unit(Frame& F, int h, int c) {
    gla_stage<0>(F, h, c);
    const int l = F.lane, i16 = l & 15, g = l >> 4, q = i16 >> 2, p = i16 & 3, w = F.wave;
    f32x4 acc[8][2];
#pragma unroll
    for (int dt = 0; dt < 8; ++dt) { acc[dt][0] = (f32x4){0.f, 0.f, 0.f, 0.f}; acc[dt][1] = (f32x4){0.f, 0.f, 0.f, 0.f}; }
#pragma unroll
    for (int ks = 0; ks < 2; ++ks) { const int r0 = 32 * ks + 4 * g + q;
        bf16x8 B[2];
#pragma unroll
        for (int ei = 0; ei < 2; ++ei) { const int et = 2 * w + ei; B[ei] = cat8(TR16(F.lds + GLA_VT + r0 * 544 + (16 * et + 4 * p) * 2), TR16(F.lds + GLA_VT + (r0 + 16) * 544 + (16 * et + 4 * p) * 2)); }
#pragma unroll
        for (int dt = 0; dt < 8; ++dt) { const bf16x8 A = cat8(TR16(F.lds + GLA_KT + r0 * 288 + (16 * dt + 4 * p) * 2), TR16(F.lds + GLA_KT + (r0 + 16) * 288 + (16 * dt + 4 * p) * 2));
            acc[dt][0] = __builtin_amdgcn_mfma_f32_16x16x32_bf16(A, B[0], acc[dt][0], 0, 0, 0); acc[dt][1] = __builtin_amdgcn_mfma_f32_16x16x32_bf16(A, B[1], acc[dt][1], 0, 0, 0); } }
    float* kv = F.KVT + ((size_t)(h * 128 + c) << 15);
#pragma unroll
    for (int dt = 0; dt < 8; ++dt)
#pragma unroll
        for (int ei = 0; ei < 2; ++ei) { const int e = 16 * (2 * w + ei) + i16; *(f32x4*)(kv + e * 128 + 16 * dt + 4 * g) = acc[dt][ei]; }
}
__device__ __forceinline__ void gla_scan(Frame& F) {
    const int gt = blockIdx.x * NTHREADS + F.tid, NT = F.G * NTHREADS;
    for (int idx = gt; idx < 4 * 256 * 128; idx += NT) { const int h = idx >> 15, rem = idx & 32767, d = idx & 127; float S = 0.f;
#pragma unroll 8
        for (int c = 0; c < 128; ++c) { const size_t o = ((size_t)(h * 128 + c) << 15) + rem; F.ST[o] = (bf16)f2bf(S); S = F.DEC[(h * 128 + c) * 128 + d] * S + F.KVT[o]; } }
}
__device__ __forceinline__ void gla_pass_c_unit(Frame& F, int h, int c) {
    gla_stage<1>(F, h, c);
    const int l = F.lane, i16 = l & 15, g = l >> 4, q = i16 >> 2, p = i16 & 3, rt = F.wave >> 1, ch = F.wave & 1, t0 = c * 64;
    bf16x8 qf[4];
#pragma unroll
    for (int kd = 0; kd < 4; ++kd) qf[kd] = *(const LAS bf16x8*)(F.lds + GLA_QT + (16 * rt + i16) * 288 + (32 * kd + 8 * g) * 2);
    f32x4 pt[4];
#pragma unroll
    for (int st = 0; st < 4; ++st) { pt[st] = (f32x4){0.f, 0.f, 0.f, 0.f};
        if (st <= rt) {
#pragma unroll
            for (int kd = 0; kd < 4; ++kd) { const bf16x8 A = *(const LAS bf16x8*)(F.lds + GLA_KT + (16 * st + i16) * 288 + (32 * kd + 8 * g) * 2); pt[st] = __builtin_amdgcn_mfma_f32_16x16x32_bf16(A, qf[kd], pt[st], 0, 0, 0); }
            if (st == rt) {
#pragma unroll
                for (int i = 0; i < 4; ++i) if (4 * g + i > i16) pt[st][i] = 0.f; } } }
    f32x4 acc[8];
#pragma unroll
    for (int et = 0; et < 8; ++et) acc[et] = (f32x4){0.f, 0.f, 0.f, 0.f};
#pragma unroll
    for (int p2 = 0; p2 < 2; ++p2) {
        if (2 * p2 <= rt) { const int r0 = 32 * p2 + 4 * g + q;
            bf16x8 Bp; { const f32x4 a = pt[2 * p2], b = pt[2 * p2 + 1]; unsigned w0 = pk2(a[0], a[1]), w1 = pk2(a[2], a[3]), w2 = pk2(b[0], b[1]), w3 = pk2(b[2], b[3]); v4u t4 = {w0, w1, w2, w3}; Bp = __builtin_bit_cast(bf16x8, t4); }
#pragma unroll
            for (int et = 0; et < 8; ++et) { const int colb = (ch * 128 + 16 * et + 4 * p) * 2;
                const bf16x8 A = cat8(TR16(F.lds + GLA_VT + r0 * 544 + colb), TR16(F.lds + GLA_VT + (r0 + 16) * 544 + colb));
                acc[et] = __builtin_amdgcn_mfma_f32_16x16x32_bf16(A, Bp, acc[et], 0, 0, 0); } } }
    const bf16* stp = F.ST + ((size_t)(h * 128 + c) << 15);
#pragma unroll
    for (int kd = 0; kd < 4; ++kd)
#pragma unroll
        for (int et = 0; et < 8; ++et) { const bf16x8 A = *(const bf16x8*)(stp + (size_t)(ch * 128 + 16 * et + i16) * 128 + 32 * kd + 8 * g); acc[et] = __builtin_amdgcn_mfma_f32_16x16x32_bf16(A, qf[kd], acc[et], 0, 0, 0); }
    float ss = 0.f;
#pragma unroll
    for (int et = 0; et < 8; ++et) ss += (acc[et][0] * acc[et][0] + acc[et][1] * acc[et][1]) + (acc[et][2] * acc[et][2] + acc[et][3] * acc[et][3]);
    ss += __shfl_xor(ss, 16); ss += __shfl_xor(ss, 32);
    LAS float* rms = (LAS float*)(F.lds + GLA_RMS);
    if (g == 0) rms[(16 * rt + i16) * 2 + ch] = ss;
    __syncthreads();
    const float tot = rms[(16 * rt + i16) * 2] + rms[(16 * rt + i16) * 2 + 1];
    const float r = 1.0f / sqrtf(tot * (1.0f / 256.0f) + RMS_EPS);
    const size_t trow = (size_t)(t0 + 16 * rt + i16);
#pragma unroll
    for (int et = 0; et < 8; ++et) { const int e0 = ch * 128 + 16 * et + 4 * g;
        const f32x4 gn = *(const f32x4*)(F.gnorm + e0);
        const unsigned long long grr = *(const unsigned long long*)(F.PROJ + trow * NPROJ + C_GR + h * 256 + e0);
        const float g0 = __builtin_bit_cast(float, (unsigned)(grr << 16) & 0xffff0000u), g1 = __builtin_bit_cast(float, (unsigned)grr & 0xffff0000u), g2 = __builtin_bit_cast(float, (unsigned)(grr >> 16) & 0xffff0000u), g3 = __builtin_bit_cast(float, (unsigned)(grr >> 32) & 0xffff0000u);
        const float r0 = acc[et][0] * r * gn.x * siluf(g0), r1 = acc[et][1] * r * gn.y * siluf(g1), r2 = acc[et][2] * r * gn.z * siluf(g2), r3 = acc[et][3] * r * gn.w * siluf(g3);
        *(unsigned long long*)(F.OCAT + trow * DM + h * 256 + e0) = (unsigned long long)pk2(r0, r1) | ((unsigned long long)pk2(r2, r3) << 32); }
}

constexpr int ATT_VROW = 288, ATT_VBYTES = 32 * ATT_VROW;
__device__ __forceinline__ void attn_tile(Frame& F, int h, int q0, LAS unsigned char* vl) {
    const int l = F.lane, i16 = l & 15, g = l >> 4, q = i16 >> 2, p = i16 & 3;
    const bf16* Qp = F.PROJ + C_AQ + h * 128; const bf16* Kp = F.PROJ + C_AK + h * 128; const bf16* Vp = F.PROJ + C_AV + h * 128;
    bf16x8 qf[4];
#pragma unroll
    for (int kd = 0; kd < 4; ++kd) qf[kd] = *(const bf16x8*)(Qp + (size_t)(q0 + 16 * i16) * NPROJ + 32 * kd + 8 * g);
    f32x4 o[8];
#pragma unroll
    for (int dt = 0; dt < 8; ++dt) o[dt] = (f32x4){0.f, 0.f, 0.f, 0.f};
    float m = -1e30f, lsum = 0.f;
    for (int j = 0; j < 23; ++j) {
        const int br = j < 12 ? 0 : (j < 18 ? 1 : 2); const int r = br == 0 ? 1 : (br == 1 ? 4 : 16), stepq = 16 / r, k0 = 32 * (j - (br == 0 ? 0 : (br == 1 ? 12 : 18)));
        const int s_lo = q0 - 128 * r, kmin = max(0, 128 - q0 / r);
        const int sa_pos = max(s_lo + r * (k0 + i16), 0), sb_pos = max(s_lo + r * (k0 + 16 + i16), 0);
        bf16x8 ka[4], kb[4];
#pragma unroll
        for (int kd = 0; kd < 4; ++kd) { ka[kd] = *(const bf16x8*)(Kp + (size_t)sa_pos * NPROJ + 32 * kd + 8 * g); kb[kd] = *(const bf16x8*)(Kp + (size_t)sb_pos * NPROJ + 32 * kd + 8 * g); }
        v4u vv[8];
#pragma unroll
        for (int jj = 0; jj < 8; ++jj) { const int sp = max(s_lo + r * (k0 + 4 * jj + g), 0); vv[jj] = *(const v4u*)(Vp + (size_t)sp * NPROJ + 8 * i16); }
        f32x4 sa = {0.f, 0.f, 0.f, 0.f}, sb = {0.f, 0.f, 0.f, 0.f};
#pragma unroll
        for (int kd = 0; kd < 4; ++kd) { sa = __builtin_amdgcn_mfma_f32_16x16x32_bf16(ka[kd], qf[kd], sa, 0, 0, 0); sb = __builtin_amdgcn_mfma_f32_16x16x32_bf16(kb[kd], qf[kd], sb, 0, 0, 0); }
        const int lo = max(stepq * i16, kmin), hi = stepq * i16 + 128;
        bool va[4], vb[4]; float mx = -1e30f;
#pragma unroll
        for (int i = 0; i < 4; ++i) { const int ka_ = k0 + 4 * g + i, kb_ = ka_ + 16; va[i] = (ka_ >= lo) && (ka_ <= hi); vb[i] = (kb_ >= lo) && (kb_ <= hi);
            mx = fmaxf(mx, va[i] ? sa[i] : -1e30f); mx = fmaxf(mx, vb[i] ? sb[i] : -1e30f); }
        mx = fmaxf(mx, __shfl_xor(mx, 16)); mx = fmaxf(mx, __shfl_xor(mx, 32));
        const float mn = fmaxf(m, mx), alpha = __expf(m - mn); m = mn;
        float pa[4], pb[4]; float ps = 0.f;
#pragma unroll
        for (int i = 0; i < 4; ++i) { pa[i] = va[i] ? __expf(sa[i] - mn) : 0.f; pb[i] = vb[i] ? __expf(sb[i] - mn) : 0.f; ps += pa[i] + pb[i]; }
        lsum = lsum * alpha + ps;
        v4u pw = {pg8::cvt_pk_bf16(pa[0], pa[1]), pg8::cvt_pk_bf16(pa[2], pa[3]), pg8::cvt_pk_bf16(pb[0], pb[1]), pg8::cvt_pk_bf16(pb[2], pb[3])};
        const bf16x8 P = __builtin_bit_cast(bf16x8, pw);
#pragma unroll
        for (int jj = 0; jj < 8; ++jj) *(LAS v4u*)(vl + (4 * jj + g) * ATT_VROW + i16 * 16) = vv[jj];
#pragma unroll
        for (int dt = 0; dt < 8; ++dt) { o[dt] = o[dt] * alpha;
            const bf16x8 A = cat8(TR16(vl + (4 * g + q) * ATT_VROW + (16 * dt + 4 * p) * 2), TR16(vl + (16 + 4 * g + q) * ATT_VROW + (16 * dt + 4 * p) * 2));
            o[dt] = __builtin_amdgcn_mfma_f32_16x16x32_bf16(A, P, o[dt], 0, 0, 0); }
    }
    lsum += __shfl_xor(lsum, 16); lsum += __shfl_xor(lsum, 32);
    const float inv = 1.0f / lsum;
    bf16* op = F.OCAT + (size_t)(q0 + 16 * i16) * DM + 1024 + h * 128 + 4 * g;
#pragma unroll
    for (int dt = 0; dt < 8; ++dt) *(unsigned long long*)(op + 16 * dt) = (unsigned long long)pg8::cvt_pk_bf16(o[dt][0] * inv, o[dt][1] * inv) | ((unsigned long long)pg8::cvt_pk_bf16(o[dt][2] * inv, o[dt][3] * inv) << 32);
}
__device__ __forceinline__ void attn_phase(Frame& F) {
    LAS unsigned char* vl = F.lds + F.wave * ATT_VBYTES;
    for (int u = blockIdx.x; u < 256; u += F.G) { const int h = u & 7, B = u >> 3;
        attn_tile(F, h, 256 * B + F.wave, vl); attn_tile(F, h, 256 * B + F.wave + 8, vl); }
}

__device__ __forceinline__ void p5_glapost(Frame& F) {
    const int gw = blockIdx.x * NWAVES + F.wave, NGW = F.G * NWAVES, l = F.lane;
    for (int item = gw; item < SEQ * 4; item += NGW) {
        const int t = item >> 2, h = item & 3;
        const f32x4 o = *(const f32x4*)(F.OGRAW + (size_t)t * 1024 + h * 256 + 4 * l);
        const float ms = wave_sum(o.x * o.x + o.y * o.y + o.z * o.z + o.w * o.w) * (1.0f / 256.0f);
        const float r = 1.0f / sqrtf(ms + RMS_EPS);
        const f32x4 gn = *(const f32x4*)(F.gnorm + 4 * l);
        const bf16* gr = F.PROJ + (size_t)t * NPROJ + C_GR + h * 256 + 4 * l;
        const float r0 = o.x * r * gn.x * siluf(bf2f(gr[0])), r1 = o.y * r * gn.y * siluf(bf2f(gr[1])), r2 = o.z * r * gn.z * siluf(bf2f(gr[2])), r3 = o.w * r * gn.w * siluf(bf2f(gr[3]));
        *(unsigned long long*)(F.OCAT + (size_t)t * DM + h * 256 + 4 * l) = (unsigned long long)pk2(r0, r1) | ((unsigned long long)pk2(r2, r3) << 32);
    }
}

template <bool WRITE_U> __device__ __forceinline__ void ln_rows(Frame& F, const float* zin, float* xout, const float* g, const float* b, const float* sh, const float* sc) {
    const int gw = blockIdx.x * NWAVES + F.wave, NGW = F.G * NWAVES;
    for (int row = gw; row < SEQ; row += NGW) {
        const GAS f32x4* zr = (const GAS f32x4*)(zin + (size_t)row * DM) + F.lane;
        f32x4 v[8]; float s = 0.f;
#pragma unroll
        for (int j = 0; j < 8; ++j) { v[j] = zr[64 * j]; s += (v[j].x + v[j].y) + (v[j].z + v[j].w); }
        const float mean = wave_sum(s) * (1.0f / DM); float s2 = 0.f;
#pragma unroll
        for (int j = 0; j < 8; ++j) { v[j] = v[j] - mean; s2 += (v[j].x * v[j].x + v[j].y * v[j].y) + (v[j].z * v[j].z + v[j].w * v[j].w); }
        const float rstd = 1.0f / sqrtf(wave_sum(s2) * (1.0f / DM) + LN_EPS);
        GAS f32x4* xo = (GAS f32x4*)(xout + (size_t)row * DM) + F.lane;
        GAS unsigned long long* o8 = (GAS unsigned long long*)(F.U + (size_t)row * DM) + F.lane;
#pragma unroll
        for (int j = 0; j < 8; ++j) { const int col = 4 * F.lane + 256 * j;
            const f32x4 y = v[j] * rstd * *(const f32x4*)(g + col) + *(const f32x4*)(b + col);
            xo[64 * j] = y;
            if (WRITE_U) { const f32x4 u = y * (*(const f32x4*)(sc + col) + 1.0f) + *(const f32x4*)(sh + col);
                o8[64 * j] = (unsigned long long)pk2(u.x, u.y) | ((unsigned long long)pk2(u.z, u.w) << 32); } }
    }
}

__device__ __forceinline__ void p9_conv_naive(Frame& F) {
    const int gt = blockIdx.x * NTHREADS + F.tid, NT = F.G * NTHREADS;
    for (long idx = gt; idx < (long)SEQ * DFF; idx += NT) {
        const int t = (int)(idx / DFF), j = (int)(idx % DFF); const int pn = j >> 7, jj = j & 127, ca = 256 * pn + jj, cgc = ca + 128;
        float ya = F.conv_b[j], yg = F.conv_b[DFF + j];
#pragma unroll
        for (int i = 0; i < 3; ++i) { const int tt = t - 2 + i; if (tt >= 0) { ya += F.conv_w[i * NUP + j] * bf2f(F.H[(size_t)tt * NUP + ca]); yg += F.conv_w[i * NUP + DFF + j] * bf2f(F.H[(size_t)tt * NUP + cgc]); } }
        F.ACT[idx] = (bf16)f2bf(siluf(yg) * ya);
    }
}

__global__ void __launch_bounds__(NTHREADS, 2) mega(Args args) {
    extern __shared__ __attribute__((aligned(16))) unsigned char lds[];
    Frame F;
    F.lds = (LAS unsigned char*)lds; F.tid = threadIdx.x; F.lane = F.tid & 63; F.wave = __builtin_amdgcn_readfirstlane(F.tid >> 6); F.G = gridDim.x;
    F.x = args.in[0]; F.c = args.in[1]; F.pos = (const int*)args.in[2]; F.w_ada = args.in[3]; F.b_ada = args.in[4]; F.w_in = args.in[5]; F.w_gate = args.in[6]; F.b_gate = args.in[7];
    F.gnorm = args.in[8]; F.w_out = args.in[9]; F.ln1g = args.in[10]; F.ln1b = args.in[11]; F.w_up = args.in[12]; F.conv_w = args.in[13]; F.conv_b = args.in[14]; F.w_down = args.in[15];
    F.ln2g = args.in[16]; F.ln2b = args.in[17]; F.out = args.out; F.ws = args.ws;
    unsigned char* ws = args.ws;
    F.WinT = (bf16*)(ws + WS_WIN); F.WoutT = (bf16*)(ws + WS_WOUT); F.WupT = (bf16*)(ws + WS_WUP); F.WdownT = (bf16*)(ws + WS_WDOWN);
    F.U = (bf16*)(ws + WS_U) + U_PAD_ROWS * DM; F.PROJ = (bf16*)(ws + WS_PROJ); F.OCAT = (bf16*)(ws + WS_OCAT); F.H = (bf16*)(ws + WS_H); F.ACT = (bf16*)(ws + WS_ACT);
    F.WlrT = (bf16*)(ws + WS_MISC + MISC_WLR);
    F.MODP = (float*)(ws + WS_MISC + MISC_MODP); F.MOD = (float*)(ws + WS_MISC + MISC_MOD); F.GLR = (float*)(ws + WS_MISC + MISC_GLR);
    F.X1 = (float*)(ws + WS_X1); F.LOGA = (float*)(ws + WS_LOGA); F.OGRAW = (float*)(ws + WS_OGRAW);
    F.KVT = (float*)(ws + WS_KVT); F.DEC = (float*)(ws + WS_MISC + MISC_DEC); F.ST = (bf16*)(ws + WS_ST);
    for (int u = F.tid; u < (LDS_BYTES - RING_BYTES) / 4; u += NTHREADS) ((LAS unsigned*)(F.lds + RING_BYTES))[u] = 0u;
    __syncthreads();
    XcdBarrier bar = xcd_barrier_post((unsigned*)(ws + WS_CTL) + CW_BAR, (volatile LAS unsigned*)(F.lds + MISC_OFF) + 8);
    const int lo = args.ph_lo, hi = args.ph_hi;
#define IN(k) (lo <= (k) && (k) < hi)
#define SEAM(k) do { if (IN(k) && IN((k) + 1)) { xcd_barrier(bar); } } while (0)
    if (IN(0)) { p0_prep(F); } SEAM(0);
    if (IN(1)) { p1_u(F); } SEAM(1);
    if (IN(2)) { glr_gemm(F); pg8::Gemm g{F.U, F.WinT, SEQ, NPROJ, DM}; pg8::StaticOrder S; S.init(SEQ, NPROJ, F.G, (int)blockIdx.x);
        pg8::EpiBf16 E{F.PROJ, NPROJ, 0xF003u, QSCALE};
        pg8::gemm_phase<pg8::EpiBf16, pg8::StaticOrder, true, true>(F.lds, g, S, E); } SEAM(2);
    if (IN(3)) { p3_naive(F); for (int u = blockIdx.x; u < 512; u += F.G) gla_pass_a_unit(F, u & 3, u >> 2); } SEAM(3);
    if (IN(4)) { gla_scan(F); attn_phase(F); } SEAM(4);
    if (IN(5)) { for (int u = blockIdx.x; u < 512; u += F.G) gla_pass_c_unit(F, u & 3, u >> 2); } SEAM(5);
    if (IN(6)) { pg8::Gemm g{F.OCAT, F.WoutT, SEQ, DM, DM}; pg8::StaticOrder S; S.init(SEQ, DM, F.G, (int)blockIdx.x);
        pg8::EpiResid E{F.x, F.out, DM, F.MOD + 2 * DM, ALPHA};
        pg8::gemm_phase<pg8::EpiResid, pg8::StaticOrder, true, true>(F.lds, g, S, E); } SEAM(6);
    if (IN(7)) { ln_rows<true>(F, F.out, F.X1, F.ln1g, F.ln1b, F.MOD + 3 * DM, F.MOD + 4 * DM); } SEAM(7);
    if (IN(8)) { pg8::Gemm g{F.U - U_PAD_ROWS * DM, F.WupT, 33 * 256, NUP, DM}; pg8::StaticOrder S; S.init(33 * 256, NUP, F.G, (int)blockIdx.x);
        pg8::EpiConv E{F.ACT, F.conv_w, F.conv_b, DFF, SEQ};
        pg8::gemm_phase<pg8::EpiConv, pg8::StaticOrder, true, true, true>(F.lds, g, S, E); } SEAM(8);
    if (IN(10)) { pg8::Gemm g{F.ACT, F.WdownT, SEQ, DM, DFF}; pg8::StaticOrder S; S.init(SEQ, DM, F.G, (int)blockIdx.x);
        pg8::EpiResid E{F.X1, F.out, DM, F.MOD + 5 * DM, ALPHA};
        pg8::gemm_phase<pg8::EpiResid, pg8::StaticOrder, true, true>(F.lds, g, S, E); } SEAM(10);
    if (IN(11)) { ln_rows<false>(F, F.out, F.out, F.ln2g, F.ln2b, nullptr, nullptr); }
#undef IN
#undef SEAM
}

constexpr int NPHASES = 12;
#ifndef MK_ONE_LAUNCH
#define MK_ONE_LAUNCH 1
#endif
extern "C" void kernel_launch(void* const* d_in, const int* in_sizes, int n_in, void* d_out, int out_size, void* d_ws, size_t ws_size, hipStream_t stream) {
    static int grid = 0;
    if (grid == 0) {
        if (n_in != 18 || out_size != SEQ * DM || ws_size < WS_END) { fprintf(stderr, "kernel_launch: unexpected shapes: n_in %d out %d ws %zu\n", n_in, out_size, ws_size); grid = -1; return; }
        int dev = 0, cus = 0, per_cu = 0;
        (void)hipGetDevice(&dev); (void)hipDeviceGetAttribute(&cus, hipDeviceAttributeMultiprocessorCount, dev);
        (void)hipFuncSetAttribute((const void*)mega, hipFuncAttributeMaxDynamicSharedMemorySize, LDS_BYTES);
        (void)hipOccupancyMaxActiveBlocksPerMultiprocessor(&per_cu, (const void*)mega, NTHREADS, LDS_BYTES);
        (void)hipGetLastError();
        if (per_cu < 1) { fprintf(stderr, "kernel_launch: occupancy query says %d blocks per CU\n", per_cu); per_cu = 1; }
        grid = cus;
    }
    if (grid < 0) return;
    if (hipMemsetAsync((char*)d_ws + WS_CTL, 0, CTL_ZERO_BYTES, stream) != hipSuccess) { fprintf(stderr, "kernel_launch: memset failed\n"); return; }
    Args a{};
    for (int i = 0; i < 18; ++i) a.in[i] = (const float*)d_in[i];
    a.out = (float*)d_out; a.ws = (unsigned char*)d_ws;
#if MK_ONE_LAUNCH
    a.ph_lo = 0; a.ph_hi = NPHASES;
    void* kargs[] = {&a};
    hipError_t e = hipLaunchCooperativeKernel((const void*)mega, dim3(grid), dim3(NTHREADS), kargs, LDS_BYTES, stream);
    if (e != hipSuccess) fprintf(stderr, "cooperative launch failed: %s (grid %d)\n", hipGetErrorString(e), grid);
#else
    for (int p = 0; p < NPHASES; ++p) { a.ph_lo = p; a.ph_hi = p + 1; hipLaunchKernelGGL(mega, dim3(grid), dim3(NTHREADS), LDS_BYTES, stream, a); }
#endif
}
```
